# Optimizing an MI355X kernel written in HIP

```python
import math
import jax, jax.numpy as jnp
from jax import lax
import numpy as np

D_MODEL = 1024
BATCH = 8
SEQ = 4096
DEPTH = 2

N_MIXERS = 2
N_Q_HEADS = 16
N_KV_HEADS = 2
HEAD_DIM = 64
QKV_DIM = (N_Q_HEADS + 2 * N_KV_HEADS) * HEAD_DIM
WINDOW = 128
ATTN_BLOCK = 128
N_REL_BUCKETS = 32
REL_MAX_DISTANCE = 128
CONV_DIM = D_MODEL
CONV_WIDTH = 3
N_GROUPS = 4
EXPERTS_PER_GROUP = 8
N_EXPERTS = N_GROUPS * EXPERTS_PER_GROUP
TOP_K_IN_GROUP = 2
EXPERT_FF = 512
MOE_BLOCK = 128
RMS_EPS = 1e-5
N_ATTN_LAYERS = (DEPTH + 1) // 2
N_CONV_LAYERS = DEPTH // 2

kernel_name = "hybrid_swa_shortconv_hmoe"


def rms_norm(x, g):
    xf = x.astype(jnp.float32)
    y = xf * lax.rsqrt(jnp.mean(xf * xf, axis=-1, keepdims=True) + RMS_EPS)
    return (y * g.astype(jnp.float32)).astype(x.dtype)


def t5_causal_bucket(dist):
    max_exact = N_REL_BUCKETS // 2
    d = jnp.maximum(dist, max_exact).astype(jnp.float32)
    large = max_exact + (jnp.log(d / max_exact) / math.log(REL_MAX_DISTANCE / max_exact)
                         * (N_REL_BUCKETS - max_exact)).astype(jnp.int32)
    large = jnp.minimum(large, N_REL_BUCKETS - 1)
    return jnp.where(dist < max_exact, dist, large)


def sliding_window_attention(h, w_qkv, b_qkv, w_o, b_o, sinks, rel_bias):
    B, S, _ = h.shape
    G = N_Q_HEADS // N_KV_HEADS
    qkv = h @ w_qkv + b_qkv
    q, k, v = jnp.split(qkv, [N_Q_HEADS * HEAD_DIM, (N_Q_HEADS + N_KV_HEADS) * HEAD_DIM], axis=-1)
    q = q.reshape(B, S, N_KV_HEADS, G, HEAD_DIM) * (HEAD_DIM ** -0.5)
    k = k.reshape(B, S, N_KV_HEADS, HEAD_DIM)
    v = v.reshape(B, S, N_KV_HEADS, HEAD_DIM)
    pad = jnp.zeros((B, ATTN_BLOCK, N_KV_HEADS, HEAD_DIM), h.dtype)
    k_pad = jnp.concatenate([pad, k], axis=1)
    v_pad = jnp.concatenate([pad, v], axis=1)
    n_blocks = S // ATTN_BLOCK
    q_blocks = q.reshape(B, n_blocks, ATTN_BLOCK, N_KV_HEADS, G, HEAD_DIM).transpose(1, 0, 2, 3, 4, 5)
    qi = jnp.arange(ATTN_BLOCK)[:, None]
    kj = jnp.arange(2 * ATTN_BLOCK)[None, :]
    dist = qi + ATTN_BLOCK - kj
    in_window = (dist >= 0) & (dist < WINDOW)
    bucket = t5_causal_bucket(jnp.maximum(dist, 0))
    bias = rel_bias[bucket].astype(jnp.float32)
    bias = bias.transpose(2, 0, 1).reshape(N_KV_HEADS, G, ATTN_BLOCK, 2 * ATTN_BLOCK)
    sink = sinks.astype(jnp.float32).reshape(N_KV_HEADS, G)[:, :, None, None]

    def one_block(args):
        n, qb = args
        kb = lax.dynamic_slice_in_dim(k_pad, n * ATTN_BLOCK, 2 * ATTN_BLOCK, axis=1)
        vb = lax.dynamic_slice_in_dim(v_pad, n * ATTN_BLOCK, 2 * ATTN_BLOCK, axis=1)
        s = jnp.einsum('bqhgd,bkhd->bhgqk', qb, kb).astype(jnp.float32) + bias
        valid = in_window & ((n - 1) * ATTN_BLOCK + kj >= 0)
        s = jnp.where(valid, s, -1e30)
        m = jnp.maximum(jnp.max(s, axis=-1, keepdims=True), sink)
        p = jnp.exp(s - m)
        denom = jnp.sum(p, axis=-1, keepdims=True) + jnp.exp(sink - m)
        p = (p / denom).astype(vb.dtype)
        return jnp.einsum('bhgqk,bkhd->bqhgd', p, vb)

    o = lax.map(one_block, (jnp.arange(n_blocks), q_blocks))
    o = o.transpose(1, 0, 2, 3, 4, 5).reshape(B, S, N_Q_HEADS * HEAD_DIM)
    return o @ w_o + b_o


def gated_short_conv(h, w_in, conv_w, w_out):
    S = h.shape[1]
    b_gate, c_gate, u = jnp.split(h @ w_in, 3, axis=-1)
    z = c_gate * u
    zp = jnp.pad(z, ((0, 0), (CONV_WIDTH - 1, 0), (0, 0)))
    conv = zp[:, 0:S] * conv_w[0]
    for j in range(1, CONV_WIDTH):
        conv = conv + zp[:, j:j + S] * conv_w[j]
    return (b_gate * conv) @ w_out


def hierarchical_moe(h, w_group, b_group, w_expert, b_expert, w_gate_up, w_down):
    B, S, D = h.shape
    T = B * S
    xt = h.reshape(T, D)
    group_probs = jax.nn.softmax((xt @ w_group + b_group).astype(jnp.float32), axis=-1)
    g_prob, g_idx = lax.top_k(group_probs, 1)
    exp_logits = (xt @ w_expert + b_expert).astype(jnp.float32).reshape(T, N_GROUPS, EXPERTS_PER_GROUP)
    sel = jnp.broadcast_to(g_idx[:, :, None], (T, 1, EXPERTS_PER_GROUP))
    in_group = jnp.take_along_axis(exp_logits, sel, axis=1)[:, 0]
    e_prob, e_local = lax.top_k(jax.nn.softmax(in_group, axis=-1), TOP_K_IN_GROUP)
    e_prob = e_prob / jnp.sum(e_prob, axis=-1, keepdims=True)
    gates = g_prob * e_prob
    expert_ids = g_idx * EXPERTS_PER_GROUP + e_local

    N = T * TOP_K_IN_GROUP
    flat_e = expert_ids.reshape(N)
    flat_tok = jnp.repeat(jnp.arange(T, dtype=jnp.int32), TOP_K_IN_GROUP)
    flat_gate = gates.reshape(N)
    order = jnp.argsort(flat_e)
    sorted_e = flat_e[order]
    counts = jnp.zeros((N_EXPERTS,), jnp.int32).at[flat_e].add(1)
    padded = (counts + MOE_BLOCK - 1) // MOE_BLOCK * MOE_BLOCK
    start = jnp.cumsum(counts) - counts
    pend = jnp.cumsum(padded)
    pstart = pend - padded
    dest = pstart[sorted_e] + jnp.arange(N, dtype=jnp.int32) - start[sorted_e]
    capacity = -(-N // MOE_BLOCK) * MOE_BLOCK + N_EXPERTS * MOE_BLOCK
    slot_tok = jnp.full((capacity,), T, jnp.int32).at[dest].set(flat_tok[order])
    slot_gate = jnp.zeros((capacity,), jnp.float32).at[dest].set(flat_gate[order])
    n_blk = capacity // MOE_BLOCK
    blk_start = jnp.arange(n_blk, dtype=jnp.int32) * MOE_BLOCK
    blk_expert = jnp.minimum(jnp.searchsorted(pend, blk_start, side='right'), N_EXPERTS - 1)
    x_pad = jnp.concatenate([xt, jnp.zeros((1, D), xt.dtype)], axis=0)
    xs = x_pad[slot_tok].reshape(n_blk, MOE_BLOCK, D)

    def expert_block(args):
        xb, e = args
        g, u = jnp.split(xb @ w_gate_up[e], 2, axis=-1)
        return (jax.nn.silu(g) * u) @ w_down[e]

    ys = lax.map(expert_block, (xs, blk_expert)).reshape(capacity, D)
    out = jax.ops.segment_sum(ys * slot_gate[:, None].astype(ys.dtype), slot_tok, num_segments=T + 1)[:T]
    return out.reshape(B, S, D)


def setup_inputs(seed: int = 0) -> dict:
    key = jax.random.key(seed)
    ks = jax.random.split(key, 24)
    f32 = jnp.float32
    nrm = lambda k, shape, s: (jax.random.normal(k, shape, f32) * s)
    D = D_MODEL
    return {
        "x": nrm(ks[0], (BATCH, SEQ, D), 1.0),
        "norm_mix": 1.0 + nrm(ks[1], (DEPTH, D), 0.02),
        "norm_ffn": 1.0 + nrm(ks[2], (DEPTH, D), 0.02),
        "final_norm": 1.0 + nrm(ks[3], (D,), 0.02),
        "rel_bias": nrm(ks[4], (N_REL_BUCKETS, N_Q_HEADS), 0.5),
        "attn_w_qkv": nrm(ks[5], (N_ATTN_LAYERS, D, QKV_DIM), D ** -0.5),
        "attn_b_qkv": nrm(ks[6], (N_ATTN_LAYERS, QKV_DIM), 0.02),
        "attn_w_o": nrm(ks[7], (N_ATTN_LAYERS, N_Q_HEADS * HEAD_DIM, D), (N_Q_HEADS * HEAD_DIM) ** -0.5),
        "attn_b_o": nrm(ks[8], (N_ATTN_LAYERS, D), 0.02),
        "attn_sinks": nrm(ks[9], (N_ATTN_LAYERS, N_Q_HEADS), 1.0),
        "conv_w_in": nrm(ks[10], (N_CONV_LAYERS, D, 3 * CONV_DIM), D ** -0.5),
        "conv_w": nrm(ks[11], (N_CONV_LAYERS, CONV_WIDTH, CONV_DIM), CONV_WIDTH ** -0.5),
        "conv_w_out": nrm(ks[12], (N_CONV_LAYERS, CONV_DIM, D), CONV_DIM ** -0.5),
        "moe_w_group": nrm(ks[13], (DEPTH, D, N_GROUPS), D ** -0.5),
        "moe_b_group": nrm(ks[14], (DEPTH, N_GROUPS), 0.01),
        "moe_w_expert": nrm(ks[15], (DEPTH, D, N_EXPERTS), D ** -0.5),
        "moe_b_expert": nrm(ks[16], (DEPTH, N_EXPERTS), 0.01),
        "moe_w_gate_up": nrm(ks[17], (DEPTH, N_EXPERTS, D, 2 * EXPERT_FF), D ** -0.5),
        "moe_w_down": nrm(ks[18], (DEPTH, N_EXPERTS, EXPERT_FF, D), EXPERT_FF ** -0.5),
    }


def reference(x, norm_mix, norm_ffn, final_norm, rel_bias, attn_w_qkv, attn_b_qkv, attn_w_o,
              attn_b_o, attn_sinks, conv_w_in, conv_w, conv_w_out, moe_w_group, moe_b_group,
              moe_w_expert, moe_b_expert, moe_w_gate_up, moe_w_down):
    h = x
    for i in range(DEPTH):
        xn = rms_norm(h, norm_mix[i])
        if i % N_MIXERS == 0:
            a = i // N_MIXERS
            mix = sliding_window_attention(xn, attn_w_qkv[a], attn_b_qkv[a], attn_w_o[a],
                                           attn_b_o[a], attn_sinks[a], rel_bias)
        else:
            c = i // N_MIXERS
            mix = gated_short_conv(xn, conv_w_in[c], conv_w[c], conv_w_out[c])
        h = h + mix
        h = h + hierarchical_moe(rms_norm(h, norm_ffn[i]), moe_w_group[i], moe_b_group[i],
                                 moe_w_expert[i], moe_b_expert[i], moe_w_gate_up[i], moe_w_down[i])
    return rms_norm(h, final_norm)
```

```cpp
#include <hip/hip_runtime.h>
#include <cstdio>
#include <cstdint>

#define LAS __attribute__((address_space(3)))
#define GAS __attribute__((address_space(1)))
typedef unsigned short bf16_t;
typedef short bf16x8 __attribute__((ext_vector_type(8)));
typedef short s16x4 __attribute__((ext_vector_type(4)));
typedef float f32x4 __attribute__((ext_vector_type(4)));
typedef float f32x16 __attribute__((ext_vector_type(16)));
typedef unsigned u32x4 __attribute__((ext_vector_type(4)));
typedef unsigned u32x2 __attribute__((ext_vector_type(2)));
typedef int v8i __attribute__((ext_vector_type(8)));

#ifndef MK_N_LAUNCHES
#define MK_N_LAUNCHES 1
#endif
#ifndef ATTN_NAIVE
#define ATTN_NAIVE 0
#endif

constexpr int T = 32768, D = 1024, SEQ = 4096, QKVD = 1280, NH = 16, HD = 64;
constexpr int NE = 32, FF = 512, NA = 2 * T;
constexpr float EPS = 1e-5f, LOG2E = 1.4426950408889634f;
constexpr float QSCALE = 0.125f * LOG2E;
constexpr int NWAVES = 8, NTHR = 512;

constexpr size_t MiB = 1u << 20;
constexpr size_t WS_CTL = 0, CTL_ZERO_BYTES = 128 * 1024;
constexpr size_t WS_WQKV = 2 * MiB, WS_WO = 5 * MiB, WS_WIN = 7 * MiB, WS_WOUT = 13 * MiB, WS_WR = 15 * MiB;
constexpr size_t WS_RS0 = 16 * MiB, WS_RS2 = WS_RS0 + 128 * 1024, WS_ASCALE = WS_RS2 + 128 * 1024, WS_GATE = WS_ASCALE + 256 * 1024;
constexpr size_t WS_SSQ = 21 * MiB;
constexpr size_t WS_WGU = 32 * MiB, WS_WDN = 160 * MiB;
constexpr size_t WS_XB = 224 * MiB, WS_QKV = 288 * MiB, WS_O = 368 * MiB, WS_HA = 432 * MiB, WS_HB = 496 * MiB, WS_ACT = 560 * MiB, WS_Y = 624 * MiB, WS_H8 = 752 * MiB, WS_ELIST = 784 * MiB, WS_END = 800 * MiB;
constexpr size_t WS_BG = WS_XB, WS_Z = WS_QKV, WS_A4 = WS_O;
constexpr int CW_BAR = 4096, CW_ECNT = 16384;

constexpr int PT_OFF = 0  , MISC_OFF = 256  , LDSCTL_OFF = 256, LDSCTL_END = 512, ETAB_OFF = 512  , LISTS_OFF = 2048  , RING_OFF = 14336, RING_BYTES = 131072, LDS_BYTES = 147456;

__device__ __forceinline__ unsigned f2bf(float f) { unsigned u = __builtin_bit_cast(unsigned, f); return (u + 0x7fffu + ((u >> 16) & 1u)) >> 16; }
__device__ __forceinline__ unsigned pk2(float lo, float hi) { return f2bf(lo) | (f2bf(hi) << 16); }
__device__ __forceinline__ float bf_lo(unsigned w) { return __builtin_bit_cast(float, w << 16); }
__device__ __forceinline__ float bf_hi(unsigned w) { return __builtin_bit_cast(float, w & 0xffff0000u); }
__device__ __forceinline__ float bf2f(bf16_t h) { return __builtin_bit_cast(float, (unsigned)h << 16); }
__device__ __forceinline__ float wave_sum(float v) {
#pragma unroll
    for (int o = 1; o < 64; o <<= 1) v += __shfl_xor(v, o);
    return v;
}
__device__ __forceinline__ unsigned pk4_fp8(float a, float b, float c, float d) { int p = __builtin_amdgcn_cvt_pk_fp8_f32(a, b, 0, false); p = __builtin_amdgcn_cvt_pk_fp8_f32(c, d, p, true); return (unsigned)p; }
#define LDS_WAIT() asm volatile("s_waitcnt lgkmcnt(0)" ::: "memory")
#define VM_WAIT() asm volatile("s_waitcnt vmcnt(0)" ::: "memory")

namespace pg8 {
constexpr int BM = 256, BK = 64, HALF = 128, HTB = HALF * BK * 2, STAGE_BYTES = 8 * HTB, NXCD = 8, WGM = 8;
__host__ __device__ __forceinline__ int lds_byte(int r, int c) { const int st = (r >> 4) * 2 + (c >> 5), rr = r & 15, cc = c & 31, ob = rr * 64 + cc * 2; return st * 1024 + (ob ^ (((ob >> 9) & 1) << 5)); }
__host__ __device__ __forceinline__ void stage_rc(int b, int& R, int& C) { const int st = b / 1024, sb = b % 1024, swz = sb ^ (((sb >> 9) & 1) << 5); R = (st >> 1) * 16 + swz / 64; C = (st & 1) * 32 + (swz % 64) / 2; }
__host__ __device__ __forceinline__ int perm32(int rho) { const int n = rho >> 4, i = rho & 15; return 8 * (i >> 2) + 4 * n + (i & 3); }
__device__ __forceinline__ unsigned cvt_pk_bf16(float lo, float hi) { unsigned r; asm volatile("v_cvt_pk_bf16_f32 %0, %1, %2" : "=v"(r) : "v"(lo), "v"(hi)); return r; }

struct Unit { int pm, pn, nrows; const char* bptr; const int* list; };

__device__ __forceinline__ int xcd_remap(int L, int nwg) { const int q = nwg / NXCD, r = nwg % NXCD, xcd = L % NXCD, off = L / NXCD; return (xcd < r ? xcd * (q + 1) : r * (q + 1) + (xcd - r) * q) + off; }

typedef f32x4 Acc[2][2][4][2];

template <class P>
__device__ __forceinline__ void gemm_phase(LAS unsigned char* lds, LAS unsigned char* ctl, const int tid, const P& p) {
    const int wid = __builtin_amdgcn_readfirstlane(tid >> 6), lane = tid & 63, wr = wid >> 2, wc = wid & 3, fr = lane & 15, fq = lane >> 4;
    const int K = p.K, nt = K / BK;
    unsigned voffB[2];
#pragma unroll
    for (int i = 0; i < 2; ++i) { int R, C; stage_rc(tid * 16 + i * 8192, R, C);
        const int Rb = P::WIDE ? (64 * (R >> 5) + 16 * ((R >> 2) & 3) + 4 * ((R >> 4) & 1) + (R & 3)) : ((R & ~31) + perm32(R & 31)); voffB[i] = (unsigned)(Rb * K + C) * 2u; }
    const size_t kstep = (size_t)(BK * 2);
    const size_t hstep = (size_t)(P::WIDE ? 8 : HALF) * K * 2;
    const unsigned ldsw = (unsigned)wid * 1024u;
    const int aoff = lds_byte(wr * 64 + fr, fq * 8), boff = lds_byte(wc * 32 + fr, fq * 8);
    LAS int* const lists = (LAS int*)(ctl + LISTS_OFF);
#define PG8_SA(b, h) (((b) * 2 + (h)) * HTB)
#define PG8_SB(b, h) ((4 + (b) * 2 + (h)) * HTB)
#define PG8_STAGE(bufoff, gbase, voff) do { _Pragma("unroll") for (int _i = 0; _i < 2; ++_i) \
        __builtin_amdgcn_global_load_lds((const unsigned*)((const char*)(gbase) + (voff)[_i]), (LAS unsigned*)(lds + (bufoff) + ldsw + _i * 8192), 16, 0, 0); } while (0)
#define PG8_LDA(dst, b, h) do { _Pragma("unroll") for (int m = 0; m < 4; ++m) _Pragma("unroll") for (int k = 0; k < 2; ++k) dst[m][k] = *(const LAS bf16x8*)(lds + PG8_SA(b, h) + aoff + m * 2048 + k * 1024); } while (0)
#define PG8_LDB(dst, b, h) do { _Pragma("unroll") for (int n = 0; n < 2; ++n) _Pragma("unroll") for (int k = 0; k < 2; ++k) dst[n][k] = *(const LAS bf16x8*)(lds + PG8_SB(b, h) + boff + n * 2048 + k * 1024); } while (0)
#define PG8_LDA8(dst, b, h) do { _Pragma("unroll") for (int m = 0; m < 4; ++m) { const u32x4 lo_ = *(const LAS u32x4*)(lds + PG8_SA(b, h) + aoff + m * 2048), hi_ = *(const LAS u32x4*)(lds + PG8_SA(b, h) + aoff + m * 2048 + 1024); \
        dst[m] = (v8i){(int)lo_.x, (int)lo_.y, (int)lo_.z, (int)lo_.w, (int)hi_.x, (int)hi_.y, (int)hi_.z, (int)hi_.w}; } } while (0)
#define PG8_LDB8(dst, b, h) do { _Pragma("unroll") for (int n = 0; n < 2; ++n) { const u32x4 lo_ = *(const LAS u32x4*)(lds + PG8_SB(b, h) + boff + n * 2048), hi_ = *(const LAS u32x4*)(lds + PG8_SB(b, h) + boff + n * 2048 + 1024); \
        dst[n] = (v8i){(int)lo_.x, (int)lo_.y, (int)lo_.z, (int)lo_.w, (int)hi_.x, (int)hi_.y, (int)hi_.z, (int)hi_.w}; } } while (0)
#define PG8_MMA8(ai, bj, At, Bt) do { __builtin_amdgcn_s_setprio(1); _Pragma("unroll") for (int m = 0; m < 4; ++m) _Pragma("unroll") for (int n = 0; n < 2; ++n) \
        acc[ai][bj][m][n] = __builtin_amdgcn_mfma_scale_f32_16x16x128_f8f6f4(Bt[n], At[m], acc[ai][bj][m][n], 0, 0, 0, p.scale_w, 0, p.scale_a); __builtin_amdgcn_s_setprio(0); } while (0)
#define PG8_MMA(ai, bj, At, Bt) do { __builtin_amdgcn_s_setprio(1); _Pragma("unroll") for (int m = 0; m < 4; ++m) _Pragma("unroll") for (int n = 0; n < 2; ++n) _Pragma("unroll") for (int k = 0; k < 2; ++k) \
        acc[ai][bj][m][n] = __builtin_amdgcn_mfma_f32_16x16x32_bf16(Bt[n][k], At[m][k], acc[ai][bj][m][n], 0, 0, 0); __builtin_amdgcn_s_setprio(0); } while (0)
#define PG8_WAIT_V(n) asm volatile("s_waitcnt vmcnt(" #n ")" ::: "memory")
#define PG8_WAIT_L(n) asm volatile("s_waitcnt lgkmcnt(" #n ")" ::: "memory")
#define PG8_WAIT_VR() do { if (EO > 0 && relax) asm volatile("s_waitcnt vmcnt(%0)" :: "n"(8 + EO) : "memory"); else PG8_WAIT_V(8); } while (0)
#define PG8_BAR __builtin_amdgcn_s_barrier()
#define PG8_SCHED __builtin_amdgcn_sched_barrier(0)
#define PG8_ZERO_ACC() do { _Pragma("unroll") for (int a = 0; a < 2; ++a) _Pragma("unroll") for (int b = 0; b < 2; ++b) _Pragma("unroll") for (int m = 0; m < 4; ++m) _Pragma("unroll") for (int n = 0; n < 2; ++n) acc[a][b][m][n] = (f32x4){0.f, 0.f, 0.f, 0.f}; } while (0)
    constexpr int EO = P::EPI_OPS;
    Unit cur, nxt; int ui = 0;
    if (!p.next(0, cur)) return;
    if constexpr (P::SIDE) {
        if (wid == 0) __builtin_amdgcn_global_load_lds((const unsigned*)(p.side + (size_t)cur.pm * 256 + lane * 4), (LAS unsigned*)(ctl + LISTS_OFF), 16, 0, 0);
        PG8_WAIT_V(0); PG8_BAR; asm volatile("" ::: "memory");
    }
    if constexpr (P::GATHER) {
        if (wid < 4) __builtin_amdgcn_global_load_lds((const unsigned*)(cur.list + (wid * 64 + lane) * 4), (LAS unsigned*)(ctl + LISTS_OFF + wid * 1024), 16, 0, 0);
        PG8_WAIT_V(0); PG8_BAR; asm volatile("" ::: "memory");
    }
    Acc acc; PG8_ZERO_ACC();
    bf16x8 At[4][2], B0[2][2], B1[2][2];
    v8i At8[4], B08[2], B18[2];
    unsigned voffA[2][2];
    p.a_off(cur, lists, tid, voffA);
    const char* const cA = p.Abase; const char* cB = cur.bptr;
    PG8_STAGE(PG8_SB(0, 0), cB, voffB); PG8_STAGE(PG8_SB(0, 1), cB + hstep, voffB); PG8_STAGE(PG8_SA(0, 0), cA, voffA[0]); PG8_STAGE(PG8_SA(0, 1), cA, voffA[1]);
    if (wr == 1) PG8_BAR;
    PG8_WAIT_V(2); PG8_BAR;
    PG8_STAGE(PG8_SB(1, 0), cB + kstep, voffB); PG8_STAGE(PG8_SA(1, 0), cA + kstep, voffA[0]); PG8_STAGE(PG8_SB(1, 1), cB + hstep + kstep, voffB);
    PG8_WAIT_V(6); PG8_BAR;
    if constexpr (EO > 0) PG8_STAGE(PG8_SA(1, 1), cA + kstep, voffA[1]);
    for (;;) {
        const bool has_next = p.next(ui + 1, nxt);
        if constexpr (P::GATHER) {
            if (has_next && wid < 4) __builtin_amdgcn_global_load_lds((const unsigned*)(nxt.list + (wid * 64 + lane) * 4), (LAS unsigned*)(ctl + LISTS_OFF + ((ui + 1) % 3) * 4096 + wid * 1024), 16, 0, 0);
        }
        if constexpr (P::SIDE) { if (has_next && wid == 0) __builtin_amdgcn_global_load_lds((const unsigned*)(p.side + (size_t)nxt.pm * 256 + lane * 4), (LAS unsigned*)(ctl + LISTS_OFF + ((ui + 1) % 3) * 4096), 16, 0, 0); }
        const char* nB = has_next ? nxt.bptr : cB;
#pragma unroll 1
        for (int t = 0; t < nt; t += 2) {
            const bool last = (t == nt - 2);
            const bool relax = (EO > 0) && (t == 0) && (ui > 0);
            const char* a1 = cA + (size_t)(t + 1) * kstep;
            const char* a2 = last ? cA : cA + (size_t)(t + 2) * kstep; const char* b2 = last ? nB : cB + (size_t)(t + 2) * kstep;
            const char* a3 = a2 + kstep; const char* b3 = b2 + kstep;
            if constexpr (!P::FP8) {
            PG8_LDB(B0, 0, 0); PG8_LDB(B1, 0, 1); PG8_SCHED; PG8_LDA(At, 0, 0); if (EO == 0 || t != 0) PG8_STAGE(PG8_SA(1, 1), a1, voffA[1]);
            if (last && has_next) p.a_off(nxt, lists + ((ui + 1) % 3) * 1024, tid, voffA);
            PG8_WAIT_VR(); PG8_WAIT_L(0); PG8_BAR; PG8_MMA(0, 0, At, B0); PG8_MMA(0, 1, At, B1); PG8_BAR; PG8_SCHED;
            PG8_LDA(At, 0, 1); PG8_STAGE(PG8_SB(0, 0), b2, voffB); PG8_STAGE(PG8_SB(0, 1), b2 + hstep, voffB); PG8_STAGE(PG8_SA(0, 0), a2, voffA[0]);
            PG8_WAIT_VR(); PG8_WAIT_L(0); PG8_BAR; PG8_MMA(1, 0, At, B0); PG8_MMA(1, 1, At, B1); PG8_BAR; PG8_SCHED;
            PG8_LDB(B0, 1, 0); PG8_LDB(B1, 1, 1); PG8_SCHED; PG8_LDA(At, 1, 0); PG8_STAGE(PG8_SA(0, 1), a2, voffA[1]);
            PG8_WAIT_VR(); PG8_WAIT_L(0); PG8_BAR; PG8_MMA(0, 0, At, B0); PG8_MMA(0, 1, At, B1); PG8_BAR; PG8_SCHED;
            PG8_LDA(At, 1, 1); PG8_STAGE(PG8_SB(1, 0), b3, voffB); PG8_STAGE(PG8_SB(1, 1), b3 + hstep, voffB); PG8_STAGE(PG8_SA(1, 0), a3, voffA[0]);
            PG8_WAIT_V(8); PG8_WAIT_L(0); PG8_BAR; PG8_MMA(1, 0, At, B0); PG8_MMA(1, 1, At, B1); PG8_BAR; PG8_SCHED;
            } else {
            PG8_LDB8(B08, 0, 0); PG8_LDB8(B18, 0, 1); PG8_SCHED; PG8_LDA8(At8, 0, 0); PG8_STAGE(PG8_SA(1, 1), a1, voffA[1]);
            if (last && has_next) p.a_off(nxt, lists + ((ui + 1) % 3) * 1024, tid, voffA);
            PG8_WAIT_V(8); PG8_WAIT_L(0); PG8_BAR; PG8_MMA8(0, 0, At8, B08); PG8_MMA8(0, 1, At8, B18); PG8_BAR; PG8_SCHED;
            PG8_LDA8(At8, 0, 1); PG8_STAGE(PG8_SB(0, 0), b2, voffB); PG8_STAGE(PG8_SB(0, 1), b2 + hstep, voffB); PG8_STAGE(PG8_SA(0, 0), a2, voffA[0]);
            PG8_WAIT_V(8); PG8_WAIT_L(0); PG8_BAR; PG8_MMA8(1, 0, At8, B08); PG8_MMA8(1, 1, At8, B18); PG8_BAR; PG8_SCHED;
            PG8_LDB8(B08, 1, 0); PG8_LDB8(B18, 1, 1); PG8_SCHED; PG8_LDA8(At8, 1, 0); PG8_STAGE(PG8_SA(0, 1), a2, voffA[1]);
            PG8_WAIT_V(8); PG8_WAIT_L(0); PG8_BAR; PG8_MMA8(0, 0, At8, B08); PG8_MMA8(0, 1, At8, B18); PG8_BAR; PG8_SCHED;
            PG8_LDA8(At8, 1, 1); PG8_STAGE(PG8_SB(1, 0), b3, voffB); PG8_STAGE(PG8_SB(1, 1), b3 + hstep, voffB); PG8_STAGE(PG8_SA(1, 0), a3, voffA[0]);
            PG8_WAIT_V(8); PG8_WAIT_L(0); PG8_BAR; PG8_MMA8(1, 0, At8, B08); PG8_MMA8(1, 1, At8, B18); PG8_BAR; PG8_SCHED;
            }
        }
        if (wr == 0) PG8_BAR;
        if constexpr (EO > 0) { if (has_next) PG8_STAGE(PG8_SA(1, 1), cA + kstep, voffA[1]); asm volatile("" ::: "memory"); }
        if constexpr (!P::AFTER_DRAIN) p.epi(acc, cur, lists + (ui % 3) * 1024, wr, wc, fr, fq);
        asm volatile("" ::: "memory");
        if (!has_next) break;
        PG8_ZERO_ACC();
        cur = nxt; cB = nB; ++ui;
        if (wr == 1) PG8_BAR;
    }
    PG8_WAIT_V(0);
    PG8_BAR;
    asm volatile("" ::: "memory");
    if constexpr (P::AFTER_DRAIN) p.epi(acc, cur, lists + (ui % 3) * 1024, wr, wc, fr, fq);
#undef PG8_SA
#undef PG8_SB
#undef PG8_STAGE
#undef PG8_LDA
#undef PG8_LDB
#undef PG8_MMA
#undef PG8_MMA8
#undef PG8_LDA8
#undef PG8_LDB8
#undef PG8_WAIT_V
#undef PG8_WAIT_L
#undef PG8_WAIT_VR
#undef PG8_BAR
#undef PG8_SCHED
#undef PG8_ZERO_ACC
}
}

#define XB_TMO      128
#define XB_XCNT(j)  (256  + 64 * (j))
#define XB_XSUB(j)  (1280 + 64 * (j))
#define XB_XGEN(j)  (2304 + 64 * (j))
#define XB_TOP      3328
#define XB_TOPGEN   3392
#define XCD_BAR_WORDS 3456
#define XB_SPIN_CAP (1u << 22)
__device__ __forceinline__ unsigned xb_ld(unsigned* p)              { return __hip_atomic_load(p, __ATOMIC_RELAXED, __HIP_MEMORY_SCOPE_AGENT); }
__device__ __forceinline__ unsigned xb_add(unsigned* p, unsigned v) { return __hip_atomic_fetch_add(p, v, __ATOMIC_RELAXED, __HIP_MEMORY_SCOPE_AGENT); }
__device__ __forceinline__ unsigned xb_xcc_id() { return (unsigned)__builtin_amdgcn_s_getreg((3 << 11) | 20) & 0xFu; }
#define XB_SPIN(cond, bar) do { unsigned _sp = 0; while (cond) { __builtin_amdgcn_s_sleep(1); \
    if ((++_sp & 255u) == 0u) { if (xb_ld(&(bar)[XB_TMO])) break; if (_sp > XB_SPIN_CAP) { atomicAdd(&(bar)[XB_TMO], 1u); break; } } } } while (0)
struct XcdBarrier { unsigned* bar; unsigned x; volatile LAS unsigned* st; };
__device__ __forceinline__ XcdBarrier xcd_barrier_post(unsigned* bar, volatile LAS unsigned* st) {
    XcdBarrier b; b.bar = bar; b.x = xb_xcc_id(); b.st = st;
    if (threadIdx.x == 0) (void)xb_add(&bar[XB_XCNT(b.x)], 1u);
    return b;
}
__device__ __forceinline__ void xcd_barrier_complete(unsigned* bar, unsigned x, unsigned& nloc, unsigned& nx) {
    const unsigned G = gridDim.x * gridDim.y * gridDim.z;
    unsigned sum, cnt, mine, sp = 0u;
    for (;;) {
        sum = 0u; cnt = 0u; mine = 0u;
#pragma unroll
        for (unsigned j = 0; j < 16; ++j) { const unsigned c = xb_ld(&bar[XB_XCNT(j)]); sum += c; cnt += (c > 0u) ? 1u : 0u; mine = (j == x) ? c : mine; }
        if (sum == G) break;
        __builtin_amdgcn_s_sleep(1);
        if ((++sp & 255u) == 0u) { if (xb_ld(&bar[XB_TMO])) break; if (sp > XB_SPIN_CAP) { atomicAdd(&bar[XB_TMO], 1u); break; } }
    }
    nloc = mine > 0u ? mine : 1u; nx = cnt > 0u ? cnt : 1u;
}
__device__ __forceinline__ void xcd_barrier(const XcdBarrier& b) {
    asm volatile("s_waitcnt vmcnt(0)" ::: "memory");
    __syncthreads();
    if (threadIdx.x == 0) {
        unsigned* bar = b.bar;
        __builtin_amdgcn_s_waitcnt(0);
        unsigned nloc = b.st[0], nx = b.st[1];
        if (nloc == 0u) { xcd_barrier_complete(bar, b.x, nloc, nx); b.st[0] = nloc; b.st[1] = nx; }
        const unsigned old = xb_add(&bar[XB_XSUB(b.x)], 1u);
        const unsigned gen = old / nloc;
        if (old + 1u == (gen + 1u) * nloc) {
            __builtin_amdgcn_fence(__ATOMIC_RELEASE, "agent");
            asm volatile("s_waitcnt vmcnt(0)" ::: "memory");
            const unsigned og = xb_add(&bar[XB_TOP], 1u);
            const unsigned tg = og / nx;
            if (og + 1u == (tg + 1u) * nx) xb_add(&bar[XB_TOPGEN], 1u);
            else XB_SPIN(xb_ld(&bar[XB_TOPGEN]) == tg, bar);
            __builtin_amdgcn_fence(__ATOMIC_ACQUIRE, "agent");
            xb_add(&bar[XB_XGEN(b.x)], 1u);
            asm volatile("s_waitcnt vmcnt(0)" ::: "memory");
        } else {
            XB_SPIN(xb_ld(&bar[XB_XGEN(b.x)]) == gen, bar);
            __builtin_amdgcn_fence(__ATOMIC_ACQUIRE, "agent");
            asm volatile("s_waitcnt vmcnt(0)" ::: "memory");
        }
    }
    __syncthreads();
}

struct Args { const float* in[19]; float* out; unsigned char* ws; int ph_lo, ph_hi, li, pad; };

struct Frame {
    LAS unsigned char* lds;
    int tid, lane, wave, G, bid;
};
__device__ __forceinline__ unsigned long long pt_get(const Frame& F, int i) { const unsigned long long v = ((volatile LAS unsigned long long*)(F.lds + PT_OFF))[i];
    return ((unsigned long long)(unsigned)__builtin_amdgcn_readfirstlane((int)(v >> 32)) << 32) | (unsigned long long)(unsigned)__builtin_amdgcn_readfirstlane((int)(unsigned)v); }
#define IN_F(i) ((const float*)(GAS const float*)pt_get(F, (i)))
#define WSP ((unsigned char*)(GAS unsigned char*)pt_get(F, 19))
#define OUTP ((float*)(GAS float*)pt_get(F, 20))

struct TItem { const float* src; unsigned char* dst; const float* g; int N, K; float sc; };
__device__ __forceinline__ int gu_row(int n, int half) { return n < half ? ((n >> 7) * 256 + (n & 127)) : (((n - half) >> 7) * 256 + 128 + ((n - half) & 127)); }
__device__ __forceinline__ void ti_load(const TItem& t, f32x4 (&v)[16], int lane) {
    const float* p = t.src + (size_t)(16 * (lane >> 4)) * t.N + 4 * (lane & 15);
#pragma unroll
    for (int i = 0; i < 16; ++i) v[i] = __builtin_nontemporal_load((const f32x4*)(p + (size_t)i * t.N));
}
__device__ __forceinline__ void ti_store(const TItem& t, f32x4 (&v)[16], int lane) {
    const int kq = lane >> 4, nq = lane & 15;
    if (t.g) {
#pragma unroll
        for (int q = 0; q < 4; ++q) { const f32x4 gv = *(const f32x4*)(t.g + 16 * kq + 4 * q);
#pragma unroll
            for (int e = 0; e < 4; ++e) v[4 * q + e] = v[4 * q + e] * gv[e]; }
    }
    if (t.sc == 0.f) {
        unsigned char* d = t.dst + ((size_t)(4 * nq) * t.K + 16 * kq) * 2;
#pragma unroll
        for (int j = 0; j < 4; ++j)
#pragma unroll
            for (int c = 0; c < 2; ++c) { u32x4 o;
                o.x = pg8::cvt_pk_bf16(v[8 * c + 0][j], v[8 * c + 1][j]); o.y = pg8::cvt_pk_bf16(v[8 * c + 2][j], v[8 * c + 3][j]);
                o.z = pg8::cvt_pk_bf16(v[8 * c + 4][j], v[8 * c + 5][j]); o.w = pg8::cvt_pk_bf16(v[8 * c + 6][j], v[8 * c + 7][j]);
                *(u32x4*)(d + ((size_t)j * t.K + 8 * c) * 2) = o; }
    } else {
        unsigned char* d = t.dst + (size_t)(4 * nq) * t.K + 16 * kq; const float sc = t.sc;
#pragma unroll
        for (int j = 0; j < 4; ++j) { u32x4 o;
            o.x = pk4_fp8(v[0][j] * sc, v[1][j] * sc, v[2][j] * sc, v[3][j] * sc); o.y = pk4_fp8(v[4][j] * sc, v[5][j] * sc, v[6][j] * sc, v[7][j] * sc);
            o.z = pk4_fp8(v[8][j] * sc, v[9][j] * sc, v[10][j] * sc, v[11][j] * sc); o.w = pk4_fp8(v[12][j] * sc, v[13][j] * sc, v[14][j] * sc, v[15][j] * sc);
            *(u32x4*)(d + (size_t)j * t.K) = o; }
    }
}

constexpr int I_QKV = 16 * 20, I_O = 16 * 16, I_IN = 16 * 48, I_OUT = 16 * 16, I_GU1 = 32 * 256, I_DN1 = 32 * 128;
constexpr int Q0 = I_QKV, Q_O = Q0 + I_O, Q_GU0 = Q_O + I_GU1, Q_L0 = Q_O + I_GU1 + I_DN1, Q_IN = Q_L0 + I_IN, Q_OUT = Q_IN + I_OUT, Q_GU1 = Q_OUT + I_GU1, Q_L1 = Q_OUT + I_GU1 + I_DN1, NITEMS = Q_L1;
constexpr int CW_QHEAD = 16384 + 256;
__device__ __forceinline__ void conv_resolve(const Frame& F, int it, TItem& t) {
    int r = it;
    if (r < Q0) { const int kb = r / 20, nb = r % 20; t.src = IN_F(5) + (size_t)(64 * kb) * QKVD + 64 * nb; t.dst = WSP + WS_WQKV + ((size_t)(64 * nb) * D + 64 * kb) * 2; t.g = IN_F(1) + 64 * kb; t.N = QKVD; t.K = D; t.sc = 0.f; return; } r -= Q0;
    if (r < I_O) { const int kb = r >> 4, nb = r & 15; t.src = IN_F(7) + (size_t)(64 * kb) * D + 64 * nb; t.dst = WSP + WS_WO + ((size_t)(64 * nb) * D + 64 * kb); t.g = nullptr; t.N = D; t.K = D; t.sc = 64.f; return; }   r -= I_O;
    int layer = 0;
    if (r >= I_GU1 + I_DN1) { r -= I_GU1 + I_DN1;
        if (r < I_IN) { const int kb = r / 48, nb = r % 48, n0 = 64 * nb; const int dr = n0 < 1024 ? n0 : 1024 + gu_row(n0 - 1024, 1024);
            t.src = IN_F(10) + (size_t)(64 * kb) * (3 * D) + n0; t.dst = WSP + WS_WIN + ((size_t)dr * D + 64 * kb) * 2; t.g = IN_F(1) + D + 64 * kb; t.N = 3 * D; t.K = D; t.sc = 0.f; return; } r -= I_IN;
        if (r < I_OUT) { const int kb = r >> 4, nb = r & 15; t.src = IN_F(12) + (size_t)(64 * kb) * D + 64 * nb; t.dst = WSP + WS_WOUT + ((size_t)(64 * nb) * D + 64 * kb); t.g = nullptr; t.N = D; t.K = D; t.sc = 64.f; return; }   r -= I_OUT;
        layer = 1; }
    if (r < I_GU1) { const int le = layer * 32 + (r >> 8), q = r & 255, kb = q >> 4, nb = q & 15, n0 = 64 * nb;
        t.src = IN_F(17) + (size_t)le * D * 1024 + (size_t)(64 * kb) * 1024 + n0; t.dst = WSP + WS_WGU + (size_t)le * 1024 * D + (size_t)gu_row(n0, 512) * D + 64 * kb; t.g = IN_F(2) + layer * D + 64 * kb; t.N = 1024; t.K = D; t.sc = 64.f; return; } r -= I_GU1;
    { const int le = layer * 32 + (r >> 7), q = r & 127, kb = q >> 4, nb = q & 15;
        t.src = IN_F(18) + (size_t)le * FF * D + (size_t)(64 * kb) * D + 64 * nb; t.dst = WSP + WS_WDN + (size_t)le * D * FF + (size_t)(64 * nb) * FF + 64 * kb; t.g = nullptr; t.N = D; t.K = FF; t.sc = 32.f; }
}
__device__ __forceinline__ void conv_run(const Frame& F, int first, int n) {
    const int end = (first + n) < NITEMS ? (first + n) : NITEMS;
    TItem ta, tb; f32x4 va[16], vb[16];
    int it = first + F.wave;
    if (it < end) { conv_resolve(F, it, ta); ti_load(ta, va, F.lane); }
    while (it < end) {
        const int it2 = it + NWAVES;
        if (it2 < end) { conv_resolve(F, it2, tb); ti_load(tb, vb, F.lane); }
        ti_store(ta, va, F.lane);
        if (it2 >= end) break;
        it = it2 + NWAVES;
        if (it < end) { conv_resolve(F, it, ta); ti_load(ta, va, F.lane); }
        ti_store(tb, vb, F.lane);
    }
}
__device__ __forceinline__ void conv_steal(const Frame& F, int quota, int limit, bool drain) {
    volatile LAS int* bc = (volatile LAS int*)(F.lds + MISC_OFF + 64);
    if (bc[2] >= limit) return;
    unsigned* qhead = (unsigned*)(WSP + WS_CTL) + CW_QHEAD;
    for (;;) {
        __syncthreads();
        if (F.tid == 0) { int base = -1, n = quota;
            int h = Q0 + (int)__hip_atomic_load(qhead, __ATOMIC_RELAXED, __HIP_MEMORY_SCOPE_AGENT);
            if (h < limit) { if (drain) { n = (((limit - h) + F.G - 1) / F.G + 7) & ~7; n = n < 8 ? 8 : (n > 128 ? 128 : n); }
                base = Q0 + (int)__hip_atomic_fetch_add(qhead, (unsigned)n, __ATOMIC_RELAXED, __HIP_MEMORY_SCOPE_AGENT); h = base + n; }
            bc[0] = base; bc[1] = n; if (h > bc[2]) bc[2] = h; }
        __syncthreads();
        const int base = bc[0], n = bc[1];
        if (base < 0 || base >= NITEMS) break;
        conv_run(F, base, n);
        if (!drain || base + n >= limit) break;
    }
    __syncthreads();
}

__device__ __forceinline__ void p0_prologue(Frame& F) {
    const int gw = F.bid * NWAVES + F.wave, NGW = F.G * NWAVES;
    const float* x = IN_F(0); const float* norm_ffn = IN_F(2);
    for (int it = F.bid + F.wave * F.G; it < Q0; it += NWAVES * F.G) { TItem t; f32x4 v[16]; conv_resolve(F, it, t); ti_load(t, v, F.lane); ti_store(t, v, F.lane); }
    {
        bf16_t* WR = (bf16_t*)(WSP + WS_WR); const float* wg = IN_F(13); const float* we = IN_F(15);
        const int RPW = (2 * 9 * 1024 + F.G - 1) / F.G, ZPW = (2 * 2 * 92 * 128 + F.G - 1) / F.G;
        for (int j0 = F.tid - 2 * 64; j0 >= 0 && j0 < RPW; j0 += NTHR - 2 * 64) { const int i = F.bid * RPW + j0; if (i >= 2 * 9 * 1024) break;
            const int l = i / (9 * 1024), q = (i / 1024) % 9, k = i & 1023;
            const f32x4 w4 = (q == 0) ? *(const f32x4*)(wg + (size_t)l * D * 4 + k * 4) : *(const f32x4*)(we + (size_t)l * D * 32 + k * 32 + (q - 1) * 4);
            const float g = norm_ffn[l * D + k]; const int n0 = (q == 0) ? 0 : 4 * q;
#pragma unroll
            for (int j = 0; j < 4; ++j) { const float w = w4[j] * g; const unsigned hi = f2bf(w); const float rem = w - __builtin_bit_cast(float, hi << 16);
                WR[((size_t)l * 256 + n0 + j) * 1024 + k] = (bf16_t)hi; WR[((size_t)l * 256 + 128 + n0 + j) * 1024 + k] = (bf16_t)f2bf(rem); }
        }
        for (int j0 = (F.tid + 4 * 64) % NTHR; j0 < ZPW; j0 += NTHR) { const int i = F.bid * ZPW + j0; if (i >= 2 * 2 * 92 * 128) break;
            const int l = i / (2 * 92 * 128), h = (i / (92 * 128)) & 1, r = (i / 128) % 92, c = i & 127;
            unsigned zz = 0u; asm volatile("" : "+v"(zz));
            *(u32x4*)(WR + ((size_t)l * 256 + h * 128 + 36 + r) * 1024 + c * 8) = (u32x4){zz, zz, zz, zz};
        }
    }
    {
        bf16_t* XB = (bf16_t*)(WSP + WS_XB); float* rs0 = (float*)(WSP + WS_RS0);
        for (int m = gw; m < T; m += NGW) {
            const GAS f32x4* xr = (const GAS f32x4*)(x + (size_t)m * D) + F.lane;
            f32x4 v[4]; float s = 0.f;
#pragma unroll
            for (int j = 0; j < 4; ++j) { v[j] = __builtin_nontemporal_load((const f32x4*)(x + (size_t)m * D) + F.lane + 64 * j); s += (v[j].x * v[j].x + v[j].y * v[j].y) + (v[j].z * v[j].z + v[j].w * v[j].w); }
            s = wave_sum(s);
            GAS u32x2* o8 = (GAS u32x2*)(XB + (size_t)m * D) + F.lane;
#pragma unroll
            for (int j = 0; j < 4; ++j) { u32x2 w; w.x = pk2(v[j].x, v[j].y); w.y = pk2(v[j].z, v[j].w); o8[64 * j] = w; }
            if (F.lane == 0) rs0[m] = 1.0f / sqrtf(s * (1.0f / D) + EPS);
        }
    }
}

struct DenseBase {
    static constexpr bool GATHER = false, AFTER_DRAIN = false, FP8 = false, WIDE = false, SIDE = false;
    static constexpr int EPI_OPS = 0;
    const char* Abase; const char* Bt; int K, nM, nN, nwg, G, c;
    __device__ __forceinline__ void init(const void* A, const void* B, int K_, int N, int G_, int c_) { Abase = (const char*)A; Bt = (const char*)B; K = K_; nM = T / 256; nN = N / 256; nwg = nM * nN; G = G_; c = c_; }
    __device__ __forceinline__ bool next(int i, pg8::Unit& u) const {
        const int L = i * G + c; if (L >= nwg) return false;
        const int wgid = pg8::xcd_remap(L, nwg);
        const int nig = pg8::WGM * nN, gid = wgid / nig, fm = gid * pg8::WGM, gsz = (nM - fm) < pg8::WGM ? (nM - fm) : pg8::WGM;
        u.pm = fm + ((wgid % nig) % gsz); u.pn = (wgid % nig) / gsz; u.nrows = 256; u.list = nullptr;
        u.bptr = Bt + (size_t)u.pn * 256 * K * 2; return true;
    }
    __device__ __forceinline__ void a_off(const pg8::Unit& u, LAS int*, int tid, unsigned (&voff)[2][2]) const {
#pragma unroll
        for (int i = 0; i < 2; ++i) { int R, C; pg8::stage_rc(tid * 16 + i * 8192, R, C);
#pragma unroll
            for (int h = 0; h < 2; ++h) voff[h][i] = (unsigned)((u.pm * 256 + h * 128 + R) * K + C) * 2u; }
    }
};
__device__ __forceinline__ u32x4 pack8(const f32x4& a, const f32x4& b) { u32x4 w; w.x = pg8::cvt_pk_bf16(a[0], a[1]); w.y = pg8::cvt_pk_bf16(a[2], a[3]); w.z = pg8::cvt_pk_bf16(b[0], b[1]); w.w = pg8::cvt_pk_bf16(b[2], b[3]); return w; }

__device__ __forceinline__ float sq8(const u32x4& w) { const float a = bf_lo(w.x), b = bf_hi(w.x), c = bf_lo(w.y), d = bf_hi(w.y), e = bf_lo(w.z), f = bf_hi(w.z), g = bf_lo(w.w), h = bf_hi(w.w);
    return ((a * a + b * b) + (c * c + d * d)) + ((e * e + f * f) + (g * g + h * h)); }
__device__ __forceinline__ unsigned dpp_xor1(unsigned v) { return (unsigned)__builtin_amdgcn_mov_dpp((int)v, 0xB1, 0xF, 0xF, true); }
__device__ __forceinline__ void pair_rows(u32x4& w0, u32x4& w1, int odd) {
    const u32x4 send = odd ? w0 : w1;
    u32x4 recv; recv.x = dpp_xor1(send.x); recv.y = dpp_xor1(send.y); recv.z = dpp_xor1(send.z); recv.w = dpp_xor1(send.w);
    if (odd) w0 = recv; else w1 = recv;
}
struct PolQKV : DenseBase {
    static constexpr bool WIDE = true, SIDE = true; static constexpr int EPI_OPS = 16;
    bf16_t* O; const float* side; const float* bias;
    __device__ __forceinline__ void epi(const pg8::Acc& acc, const pg8::Unit& u, LAS int* lst, int wr, int wc, int fr, int fq) const {
        const float sc = (u.pn < 4) ? QSCALE : 1.0f;
        const int col0 = u.pn * 256 + wc * 64 + 16 * fq, row0 = u.pm * 256 + wr * 64 + fr;
        f32x4 bv[2][2]; float rv[2][4];
#pragma unroll
        for (int ai = 0; ai < 2; ++ai)
#pragma unroll
            for (int m = 0; m < 4; ++m) rv[ai][m] = ((const LAS float*)lst)[wr * 64 + fr + ai * 128 + m * 16];
#pragma unroll
        for (int bj = 0; bj < 2; ++bj)
#pragma unroll
            for (int n = 0; n < 2; ++n) bv[bj][n] = *(const f32x4*)(bias + col0 + 8 * bj + 4 * n);
#pragma unroll
        for (int ai = 0; ai < 2; ++ai)
#pragma unroll
            for (int m = 0; m < 4; ++m) { const int row = row0 + ai * 128 + m * 16; const float r = rv[ai][m];
                u32x4 w[2];
#pragma unroll
                for (int bj = 0; bj < 2; ++bj) { const f32x4 v0 = (acc[ai][bj][m][0] * r + bv[bj][0]) * sc, v1 = (acc[ai][bj][m][1] * r + bv[bj][1]) * sc; w[bj] = pack8(v0, v1); }
                const int odd = fr & 1; pair_rows(w[0], w[1], odd);
                *(u32x4*)(O + (size_t)(row - odd) * QKVD + col0 + 8 * odd) = w[0]; *(u32x4*)(O + (size_t)(row - odd + 1) * QKVD + col0 + 8 * odd) = w[1]; }
    }
};
struct PolOproj : DenseBase {
    static constexpr bool WIDE = true, FP8 = true; int scale_w, scale_a;
    bf16_t* O; const bf16_t* xb; const float* bias; float* ssq; unsigned char* H8;
    __device__ __forceinline__ void epi(const pg8::Acc& acc, const pg8::Unit& u, LAS int*, int wr, int wc, int fr, int fq) const {
        const int col0 = u.pn * 256 + wc * 64 + 16 * fq, row0 = u.pm * 256 + wr * 64 + fr;
        f32x4 bv[2][2];
#pragma unroll
        for (int bj = 0; bj < 2; ++bj)
#pragma unroll
            for (int n = 0; n < 2; ++n) bv[bj][n] = *(const f32x4*)(bias + col0 + 8 * bj + 4 * n);
#pragma unroll
        for (int ai = 0; ai < 2; ++ai) {
            u32x4 hv[4][2];
#pragma unroll
            for (int m = 0; m < 4; ++m)
#pragma unroll
                for (int bj = 0; bj < 2; ++bj) hv[m][bj] = *(const u32x4*)(xb + (size_t)(row0 + ai * 128 + m * 16) * D + col0 + 8 * bj);
#pragma unroll
            for (int m = 0; m < 4; ++m) { const int row = row0 + ai * 128 + m * 16;
                u32x4 w[2];
#pragma unroll
                for (int bj = 0; bj < 2; ++bj) { const u32x4 hw = hv[m][bj];
                    const f32x4 h0 = {bf_lo(hw.x), bf_hi(hw.x), bf_lo(hw.y), bf_hi(hw.y)}, h1 = {bf_lo(hw.z), bf_hi(hw.z), bf_lo(hw.w), bf_hi(hw.w)};
                    w[bj] = pack8(acc[ai][bj][m][0] + bv[bj][0] + h0, acc[ai][bj][m][1] + bv[bj][1] + h1); }
                float sq = sq8(w[0]) + sq8(w[1]);
                u32x4 q8; q8.x = pk4_fp8(bf_lo(w[0].x), bf_hi(w[0].x), bf_lo(w[0].y), bf_hi(w[0].y)); q8.y = pk4_fp8(bf_lo(w[0].z), bf_hi(w[0].z), bf_lo(w[0].w), bf_hi(w[0].w));
                q8.z = pk4_fp8(bf_lo(w[1].x), bf_hi(w[1].x), bf_lo(w[1].y), bf_hi(w[1].y)); q8.w = pk4_fp8(bf_lo(w[1].z), bf_hi(w[1].z), bf_lo(w[1].w), bf_hi(w[1].w));
                *(u32x4*)(H8 + (size_t)row * D + col0) = q8;
                sq += __shfl_xor(sq, 16); sq += __shfl_xor(sq, 32);
                if (fq == 0) ssq[(size_t)row * 16 + u.pn * 4 + wc] = sq;
                { const int odd = fr & 1; pair_rows(w[0], w[1], odd);
                  *(u32x4*)(O + (size_t)(row - odd) * D + col0 + 8 * odd) = w[0]; *(u32x4*)(O + (size_t)(row - odd + 1) * D + col0 + 8 * odd) = w[1]; } }
            asm volatile("" ::: "memory"); }
    }
};
struct PolConvIn : DenseBase {
    static constexpr bool SIDE = true; static constexpr int EPI_OPS = 8;
    bf16_t* BG; bf16_t* Z; const float* side;
    __device__ __forceinline__ void epi(const pg8::Acc& acc, const pg8::Unit& u, LAS int* lst, int wr, int wc, int fr, int fq) const {
        const int row0 = u.pm * 256 + wr * 64 + fr;
        float rv[2][4];
#pragma unroll
        for (int ai = 0; ai < 2; ++ai)
#pragma unroll
            for (int m = 0; m < 4; ++m) rv[ai][m] = ((const LAS float*)lst)[wr * 64 + fr + ai * 128 + m * 16];
        if (u.pn < 4) {
#pragma unroll
            for (int ai = 0; ai < 2; ++ai)
#pragma unroll
                for (int m = 0; m < 4; ++m) { const int row = row0 + ai * 128 + m * 16; const float r = rv[ai][m];
#pragma unroll
                    for (int bj = 0; bj < 2; ++bj) *(u32x4*)(BG + (size_t)row * D + u.pn * 256 + bj * 128 + wc * 32 + 8 * fq) = pack8(acc[ai][bj][m][0] * r, acc[ai][bj][m][1] * r); }
        } else {
#pragma unroll
            for (int ai = 0; ai < 2; ++ai)
#pragma unroll
                for (int m = 0; m < 4; ++m) { const int row = row0 + ai * 128 + m * 16; const float r2 = rv[ai][m] * rv[ai][m];
                    *(u32x4*)(Z + (size_t)row * D + (u.pn - 4) * 128 + wc * 32 + 8 * fq) = pack8(acc[ai][0][m][0] * acc[ai][1][m][0] * r2, acc[ai][0][m][1] * acc[ai][1][m][1] * r2); }
        }
    }
};
struct PolConvOut : DenseBase {
    static constexpr bool WIDE = true, FP8 = true; int scale_w, scale_a;
    bf16_t* O; const bf16_t* H; float* ssq; unsigned char* H8;
    __device__ __forceinline__ void epi(const pg8::Acc& acc, const pg8::Unit& u, LAS int*, int wr, int wc, int fr, int fq) const {
        const int col0 = u.pn * 256 + wc * 64 + 16 * fq, row0 = u.pm * 256 + wr * 64 + fr;
        u32x4 hva[2][4][2];
#pragma unroll
        for (int ai = 0; ai < 2; ++ai)
#pragma unroll
            for (int m = 0; m < 4; ++m)
#pragma unroll
                for (int bj = 0; bj < 2; ++bj) hva[ai][m][bj] = *(const u32x4*)(H + (size_t)(row0 + ai * 128 + m * 16) * D + col0 + 8 * bj);
        asm volatile("" ::: "memory");
#pragma unroll
        for (int ai = 0; ai < 2; ++ai) {
#pragma unroll
            for (int m = 0; m < 4; ++m) { const int row = row0 + ai * 128 + m * 16;
                u32x4 w[2];
#pragma unroll
                for (int bj = 0; bj < 2; ++bj) { const u32x4 hw = hva[ai][m][bj];
                    const f32x4 h0 = {bf_lo(hw.x), bf_hi(hw.x), bf_lo(hw.y), bf_hi(hw.y)}, h1 = {bf_lo(hw.z), bf_hi(hw.z), bf_lo(hw.w), bf_hi(hw.w)};
                    w[bj] = pack8(acc[ai][bj][m][0] + h0, acc[ai][bj][m][1] + h1); }
                float sq = sq8(w[0]) + sq8(w[1]);
                u32x4 q8; q8.x = pk4_fp8(bf_lo(w[0].x), bf_hi(w[0].x), bf_lo(w[0].y), bf_hi(w[0].y)); q8.y = pk4_fp8(bf_lo(w[0].z), bf_hi(w[0].z), bf_lo(w[0].w), bf_hi(w[0].w));
                q8.z = pk4_fp8(bf_lo(w[1].x), bf_hi(w[1].x), bf_lo(w[1].y), bf_hi(w[1].y)); q8.w = pk4_fp8(bf_lo(w[1].z), bf_hi(w[1].z), bf_lo(w[1].w), bf_hi(w[1].w));
                *(u32x4*)(H8 + (size_t)row * D + col0) = q8;
                sq += __shfl_xor(sq, 16); sq += __shfl_xor(sq, 32);
                if (fq == 0) ssq[(size_t)row * 16 + u.pn * 4 + wc] = sq;
                { const int odd = fr & 1; pair_rows(w[0], w[1], odd);
                  *(u32x4*)(O + (size_t)(row - odd) * D + col0 + 8 * odd) = w[0]; *(u32x4*)(O + (size_t)(row - odd + 1) * D + col0 + 8 * odd) = w[1]; } }
            asm volatile("" ::: "memory"); }
    }
};
constexpr int RT_LG = 0, RT_RE = 40960, RT_RG = RT_RE + 2048, RT_RK = RT_RG + 2048, RT_RS = RT_RK + 2048, RT_CNT = RT_RS + 1024, RT_BASE = RT_CNT + 128;
struct PolRoute : DenseBase {
    static constexpr bool AFTER_DRAIN = true;
    LAS unsigned char* lds; const float* ssq; const float* bg; const float* be; unsigned* ecount; int* elist; float* gate; float* ascale; int tid;
    __device__ __forceinline__ void epi(const pg8::Acc& acc, const pg8::Unit& u, LAS int*, int wr, int wc, int fr, int fq) const {
        LAS float* LG = (LAS float*)(lds + RT_LG); LAS int* RE = (LAS int*)(lds + RT_RE); LAS float* RG = (LAS float*)(lds + RT_RG); LAS int* RK = (LAS int*)(lds + RT_RK);
        LAS float* RS = (LAS float*)(lds + RT_RS); LAS int* CNT = (LAS int*)(lds + RT_CNT); LAS int* BASE = (LAS int*)(lds + RT_BASE);
        if (tid < 32) CNT[tid] = 0;
        if (wc < 2) {
#pragma unroll
            for (int ai = 0; ai < 2; ++ai)
#pragma unroll
                for (int m = 0; m < 4; ++m) { const int rl = ai * 128 + wr * 64 + m * 16 + fr;
                    if (wc == 0) {
#pragma unroll
                        for (int n = 0; n < 2; ++n) *(LAS f32x4*)(LG + rl * 40 + 8 * fq + 4 * n) = acc[ai][0][m][n] + acc[ai][1][m][n];
                    } else if (fq == 0) *(LAS f32x4*)(LG + rl * 40 + 32) = acc[ai][0][m][0] + acc[ai][1][m][0]; }
        }
        __syncthreads();
        const int tok0 = u.pm * 256;
        if (tid < 256) {
            const int t = tid; const float* sp = ssq + (size_t)(tok0 + t) * 16; float sq = 0.f;
#pragma unroll
            for (int i = 0; i < 4; ++i) { const f32x4 v = *(const f32x4*)(sp + 4 * i); sq += (v[0] + v[1]) + (v[2] + v[3]); }
            const float rs = 1.0f / sqrtf(sq * (1.0f / D) + EPS);
            const LAS float* L = LG + t * 40;
            float lg[4];
#pragma unroll
            for (int j = 0; j < 4; ++j) lg[j] = L[j] * rs + bg[j];
            int gi = 0; float gm = lg[0];
#pragma unroll
            for (int j = 1; j < 4; ++j) if (lg[j] > gm) { gm = lg[j]; gi = j; }
            float gs = 0.f;
#pragma unroll
            for (int j = 0; j < 4; ++j) gs += __expf(lg[j] - gm);
            const float gp = 1.0f / gs;
            float le[8];
#pragma unroll
            for (int j = 0; j < 8; ++j) le[j] = L[4 + 8 * gi + j] * rs + be[8 * gi + j];
            int j1 = 0; float m1 = le[0];
#pragma unroll
            for (int j = 1; j < 8; ++j) if (le[j] > m1) { m1 = le[j]; j1 = j; }
            int j2 = -1; float m2 = -3.0e38f;
#pragma unroll
            for (int j = 0; j < 8; ++j) if (j != j1 && le[j] > m2) { m2 = le[j]; j2 = j; }
            const float p1 = 1.0f / (1.0f + __expf(m2 - m1));
            const int e1 = 8 * gi + j1, e2 = 8 * gi + j2;
            RS[t] = rs; RE[2 * t] = e1; RE[2 * t + 1] = e2; RG[2 * t] = gp * p1; RG[2 * t + 1] = gp * (1.0f - p1);
            RK[2 * t] = __hip_atomic_fetch_add(CNT + e1, 1, __ATOMIC_RELAXED, __HIP_MEMORY_SCOPE_WORKGROUP); RK[2 * t + 1] = __hip_atomic_fetch_add(CNT + e2, 1, __ATOMIC_RELAXED, __HIP_MEMORY_SCOPE_WORKGROUP);
        }
        __syncthreads();
        if (tid < 32) BASE[tid] = (int)__hip_atomic_fetch_add(ecount + tid, (unsigned)CNT[tid], __ATOMIC_RELAXED, __HIP_MEMORY_SCOPE_AGENT);
        __syncthreads();
        { const int i = tid, a = 2 * tok0 + i, e = RE[i];
          const float rsv = RS[i >> 1], gtv = RG[i]; u32x4 en; en.x = (unsigned)a; en.y = __float_as_uint(rsv); en.z = __float_as_uint(gtv); en.w = 0u;
          *(u32x4*)(elist + ((size_t)e * T + BASE[e] + RK[i]) * 4) = en; }
        __syncthreads();
    }
};
struct MoeBase {
    static constexpr bool GATHER = true, AFTER_DRAIN = false, FP8 = true, WIDE = false, SIDE = false;
    static constexpr int EPI_OPS = 0;
    int scale_w, scale_a;
    const char* Abase; const char* W; int K, G, c; size_t wstride;
    const int* elist; LAS int* etab;
    __device__ __forceinline__ bool next(int i, pg8::Unit& u) const {
        const int ntile = __builtin_amdgcn_readfirstlane(etab[32 + 32]), nwg = ntile * 4;
        const int L = i * G + c; if (L >= nwg) return false;
        const int wgid = pg8::xcd_remap(L, nwg);
        const int tile = wgid >> 2; u.pn = wgid & 3;
        const int em = __builtin_amdgcn_readfirstlane(etab[72 + tile]), e = em & 31, mt = em >> 5;
        const int cnt = __builtin_amdgcn_readfirstlane(etab[e]);
        u.pm = e; u.nrows = (cnt - mt * 256) < 256 ? (cnt - mt * 256) : 256;
        u.list = elist + ((size_t)e * T + mt * 256) * 4;
        u.bptr = W + (size_t)e * wstride + (size_t)u.pn * 256 * K * 2;
        return true;
    }
};
struct PolMoe1 : MoeBase {
    unsigned char* ACT; const float* ascale;
    __device__ __forceinline__ void a_off(const pg8::Unit& u, LAS int* lst, int tid, unsigned (&voff)[2][2]) const {
#pragma unroll
        for (int i = 0; i < 2; ++i) { int R, C; pg8::stage_rc(tid * 16 + i * 8192, R, C);
#pragma unroll
            for (int h = 0; h < 2; ++h) { const int rl = h * 128 + R; const int a = lst[(rl < u.nrows ? rl : 0) * 4]; voff[h][i] = (unsigned)((a >> 1) * K + C) * 2u; } }
    }
    __device__ __forceinline__ void epi(const pg8::Acc& acc, const pg8::Unit& u, LAS int* lst, int wr, int wc, int fr, int fq) const {
        int av[2][4]; float rv[2][4];
#pragma unroll
        for (int ai = 0; ai < 2; ++ai)
#pragma unroll
            for (int m = 0; m < 4; ++m) { const int rl = ai * 128 + wr * 64 + m * 16 + fr; const u32x2 en = *(const LAS u32x2*)(lst + (rl < u.nrows ? rl : 0) * 4); av[ai][m] = (int)en.x; rv[ai][m] = __uint_as_float(en.y); }
#pragma unroll
        for (int ai = 0; ai < 2; ++ai)
#pragma unroll
            for (int m = 0; m < 4; ++m) { const int rl = ai * 128 + wr * 64 + m * 16 + fr;
                if (rl < u.nrows) { const int a = av[ai][m]; const float r = rv[ai][m]; f32x4 v[2];
#pragma unroll
                    for (int n = 0; n < 2; ++n)
#pragma unroll
                        for (int j = 0; j < 4; ++j) { const float g = acc[ai][0][m][n][j] * r, uu = acc[ai][1][m][n][j] * r; v[n][j] = g * __builtin_amdgcn_rcpf(1.0f + __builtin_amdgcn_exp2f(-g * LOG2E)) * uu; }
                    u32x2 q8; q8.x = pk4_fp8(v[0][0] * 4.f, v[0][1] * 4.f, v[0][2] * 4.f, v[0][3] * 4.f); q8.y = pk4_fp8(v[1][0] * 4.f, v[1][1] * 4.f, v[1][2] * 4.f, v[1][3] * 4.f);
                    *(u32x2*)(ACT + (size_t)a * FF + u.pn * 128 + wc * 32 + 8 * fq) = q8; } }
    }
};
struct PolMoe2 : MoeBase {
    static constexpr bool WIDE = true;
    unsigned char* Y; const float* gate;
    __device__ __forceinline__ void a_off(const pg8::Unit& u, LAS int* lst, int tid, unsigned (&voff)[2][2]) const {
#pragma unroll
        for (int i = 0; i < 2; ++i) { int R, C; pg8::stage_rc(tid * 16 + i * 8192, R, C);
#pragma unroll
            for (int h = 0; h < 2; ++h) { const int rl = h * 128 + R; const int a = lst[(rl < u.nrows ? rl : 0) * 4]; voff[h][i] = (unsigned)(a * K + C) * 2u; } }
    }
    __device__ __forceinline__ void epi(const pg8::Acc& acc, const pg8::Unit& u, LAS int* lst, int wr, int wc, int fr, int fq) const {
        int av[2][4]; float gv[2][4];
#pragma unroll
        for (int ai = 0; ai < 2; ++ai)
#pragma unroll
            for (int m = 0; m < 4; ++m) { const int rl = ai * 128 + wr * 64 + m * 16 + fr; const u32x4 en = *(const LAS u32x4*)(lst + (rl < u.nrows ? rl : 0) * 4); av[ai][m] = (int)en.x; gv[ai][m] = __uint_as_float(en.z) * 16.0f; }
#pragma unroll
        for (int ai = 0; ai < 2; ++ai)
#pragma unroll
            for (int m = 0; m < 4; ++m) { const int rl = ai * 128 + wr * 64 + m * 16 + fr;
                if (rl < u.nrows) { const int a = av[ai][m]; const float g = gv[ai][m]; u32x4 q8;
#pragma unroll
                    for (int bj = 0; bj < 2; ++bj) { const f32x4 v0 = acc[ai][bj][m][0] * g, v1 = acc[ai][bj][m][1] * g; q8[2 * bj] = pk4_fp8(v0[0], v0[1], v0[2], v0[3]); q8[2 * bj + 1] = pk4_fp8(v1[0], v1[1], v1[2], v1[3]); }
                    *(u32x4*)(Y + (size_t)a * D + u.pn * 256 + wc * 64 + 16 * fq) = q8; } }
    }
};
__device__ __forceinline__ void moe_build_etab(Frame& F, const unsigned* ecount) {
    LAS int* etab = (LAS int*)(F.lds + ETAB_OFF);
    if (F.tid < 32) etab[F.tid] = (int)__hip_atomic_load(ecount + F.tid, __ATOMIC_RELAXED, __HIP_MEMORY_SCOPE_AGENT);
    __syncthreads();
    if (F.tid == 0) { int s = 0; for (int e = 0; e < 32; ++e) { etab[32 + e] = s; s += (etab[e] + 255) >> 8; } etab[64] = s; }
    __syncthreads();
    if (F.tid < etab[64] && F.tid < 288) { int e = 0; for (int j = 1; j < 32; ++j) e += (etab[32 + j] <= F.tid) ? 1 : 0; etab[72 + F.tid] = e | ((F.tid - etab[32 + e]) << 5); }
    __syncthreads();
}

constexpr int AT_K = 0, AT_V = 32768, AT_TAB = 65536, AT_WSF = AT_TAB + 16 * 384 * 4, AT_OST = AT_WSF + 8 * 64 * 4;
constexpr float ATT_SHIFT = 16.0f;
__device__ __forceinline__ int t5_bucket(int d) { if (d < 16) return d; int b = 16 + (int)(logf((float)d / 16.0f) / 2.0794415416798357f * 16.0f); return b < 31 ? b : 31; }
__device__ __forceinline__ void attn_build_tab(Frame& F) {
    LAS float* tab = (LAS float*)(F.lds + RING_OFF + AT_TAB); const float* rel = IN_F(4);
    const int d = F.tid & 127, bk = t5_bucket(d), h0 = F.tid >> 7;
    float bv[4];
#pragma unroll
    for (int i = 0; i < 4; ++i) bv[i] = rel[bk * 16 + h0 + 4 * i];
    for (int i = F.tid; i < 16 * 384; i += NTHR) { const int j = i % 384; if (j < 128 || j > 255) tab[i] = -1e30f; }
#pragma unroll
    for (int i = 0; i < 4; ++i) tab[(h0 + 4 * i) * 384 + 255 - d] = bv[i] * LOG2E - ATT_SHIFT;
    __syncthreads();
}
__device__ __forceinline__ s16x4 vtr(const LAS unsigned char* p) { typedef short v4i16_t __attribute__((ext_vector_type(4))); return __builtin_bit_cast(s16x4, __builtin_amdgcn_ds_read_tr16_b64_v4i16((LAS v4i16_t*)p)); }
__device__ __forceinline__ int crow(int r, int hi) { return (r & 3) + 8 * (r >> 2) + 4 * hi; }

#if ATTN_NAIVE
__device__ __forceinline__ void attn_phase(Frame& F) {
    attn_build_tab(F);
    const LAS float* tab = (const LAS float*)(F.lds + RING_OFF + AT_TAB);
    const bf16_t* QKV = (const bf16_t*)(WSP + WS_QKV); bf16_t* O = (bf16_t*)(WSP + WS_O); const float* sinks = IN_F(9);
    for (int idx = F.bid * NTHR + F.tid; idx < T * NH; idx += F.G * NTHR) {
        const int t = idx >> 4, h = idx & 15, hk = h >> 3, pos = t & (SEQ - 1);
        float q[64], o[64];
        const bf16_t* qp = QKV + (size_t)t * QKVD + h * 64;
#pragma unroll
        for (int d = 0; d < 64; ++d) { q[d] = bf2f(qp[d]); o[d] = 0.f; }
        float m = sinks[h] * LOG2E, l = 1.0f;
        const int k0 = pos - 127 < 0 ? 0 : pos - 127;
        for (int kp = k0; kp <= pos; ++kp) {
            const bf16_t* kr = QKV + (size_t)(t - pos + kp) * QKVD + 1024 + hk * 64; const bf16_t* vr = kr + 128;
            float s = 0.f;
#pragma unroll
            for (int d = 0; d < 64; ++d) s += q[d] * bf2f(kr[d]);
            s += tab[h * 384 + 255 - (pos - kp)];
            const float mn = fmaxf(m, s), al = __builtin_amdgcn_exp2f(m - mn), pp = __builtin_amdgcn_exp2f(s - mn);
            l = l * al + pp; m = mn;
#pragma unroll
            for (int d = 0; d < 64; ++d) o[d] = o[d] * al + pp * bf2f(vr[d]);
        }
        const float rl = 1.0f / l; bf16_t* op = O + (size_t)t * D + h * 64;
#pragma unroll
        for (int d = 0; d < 64; d += 2) *(unsigned*)(op + d) = pk2(o[d] * rl, o[d + 1] * rl);
    }
    __syncthreads();
}
#else
__device__ __forceinline__ void attn_phase(Frame& F) {
    attn_build_tab(F);
    const int lane = F.lane, wid = F.wave, r32 = lane & 31, hi = lane >> 5;
    const bf16_t* QKV = (const bf16_t*)(WSP + WS_QKV); unsigned char* O = WSP + WS_O; const float* sinks = IN_F(9);
    LAS unsigned char* const lds = F.lds + RING_OFF;
    LAS float* wsf = (LAS float*)(lds + AT_WSF) + wid * 64;
    const LAS unsigned char* vp0 = lds + AT_V + ((lane >> 4) & 1) * 32 + (lane & 3) * 8 + (4 * hi + ((lane & 15) >> 2)) * 64;
    LAS unsigned char* stg = lds + AT_OST + wid * 4096;
    bf16x8 qn[4];
    { const int unit = F.bid; if (unit < 512) { const int b = unit >> 6, n = (unit & 63) >> 1, h = (unit & 1) * 8 + wid; const size_t qrow = (size_t)b * SEQ + (size_t)(128 * n + r32);
#pragma unroll
        for (int d0 = 0; d0 < 4; ++d0) qn[d0] = *(const bf16x8*)(QKV + qrow * QKVD + h * 64 + d0 * 16 + hi * 8); } }
    u32x4 kvr[8];
    auto kv_load = [&](int unit) {
        const int b = unit >> 6, n = (unit & 63) >> 1, hk = unit & 1; const size_t rowb = (size_t)b * SEQ;
#pragma unroll
        for (int i = 0; i < 4; ++i) {
            const int p = wid * 4 + i, slot = p >> 3;
            if (n > 0 || slot >= 2) {
                { const int chunk = p & 7, key = slot * 64 + lane; const size_t row = rowb + (size_t)(128 * (n - 1) + key); kvr[2 * i] = *(const u32x4*)(QKV + row * QKVD + 1024 + hk * 64 + chunk * 8); }
                { const int dh = (p >> 2) & 1, rg = p & 3, key = slot * 64 + rg * 16 + (lane >> 2); const size_t row = rowb + (size_t)(128 * (n - 1) + key); kvr[2 * i + 1] = *(const u32x4*)(QKV + row * QKVD + 1152 + hk * 64 + dh * 32 + (lane & 3) * 8); }
            }
        }
    };
    if (F.bid < 512) kv_load(F.bid);
    for (int unit = F.bid; unit < 512; unit += F.G) {
        const int b = unit >> 6, n = (unit & 63) >> 1, hk = unit & 1;
        const size_t rowb = (size_t)b * SEQ;
#pragma unroll
        for (int i = 0; i < 4; ++i) {
            const int p = wid * 4 + i, slot = p >> 3;
            if (n > 0 || slot >= 2) { *(LAS u32x4*)(lds + AT_K + p * 1024 + lane * 16) = kvr[2 * i]; *(LAS u32x4*)(lds + AT_V + p * 1024 + lane * 16) = kvr[2 * i + 1]; }
        }
        __syncthreads();
        if (unit + F.G < 512) kv_load(unit + F.G);
        const int h = hk * 8 + wid;
        const LAS float* tabh = (const LAS float*)(lds + AT_TAB) + h * 384;
        const float sinkp = __builtin_amdgcn_exp2f(sinks[h] * LOG2E - ATT_SHIFT);
        for (int a = 0; a < 4; ++a) {
            bf16x8 qr[4];
#pragma unroll
            for (int d0 = 0; d0 < 4; ++d0) qr[d0] = qn[d0];
            { int nu = unit, na = a + 1; if (na == 4) { na = 0; nu = unit + F.G; }
              if (nu < 512) { const int nb = nu >> 6, nn = (nu & 63) >> 1, nh = (nu & 1) * 8 + wid; const size_t qrow = (size_t)nb * SEQ + (size_t)(128 * nn + 32 * na + r32);
#pragma unroll
                for (int d0 = 0; d0 < 4; ++d0) qn[d0] = *(const bf16x8*)(QKV + qrow * QKVD + nh * 64 + d0 * 16 + hi * 8); } }
            float lrun = (hi == 0) ? sinkp : 0.0f;
            f32x16 o0 = {}, o1 = {};
            int jt_lo = (a < 2) ? 0 : 1; const int jt_hi = (a < 2) ? 2 : 3;
            if (n == 0 && jt_lo < 2) jt_lo = 2;
            for (int jt = jt_lo; jt <= jt_hi; ++jt) {
                const LAS unsigned char* kb = lds + AT_K + jt * 8192 + hi * 1024 + r32 * 16;
                const LAS float* tp = tabh + (127 - (32 * a + r32) + 4 * hi) + 64 * jt;
                f32x16 p0, p1;
#pragma unroll
                for (int r = 0; r < 16; ++r) { const int ko = (r & 3) + 8 * (r >> 2); p0[r] = tp[ko]; p1[r] = tp[32 + ko]; }
#pragma unroll
                for (int d0 = 0; d0 < 4; ++d0) {
                    const bf16x8 b0 = *(const LAS bf16x8*)(kb + d0 * 2048), b1 = *(const LAS bf16x8*)(kb + d0 * 2048 + 512);
                    p0 = __builtin_amdgcn_mfma_f32_32x32x16_bf16(b0, qr[d0], p0, 0, 0, 0);
                    p1 = __builtin_amdgcn_mfma_f32_32x32x16_bf16(b1, qr[d0], p1, 0, 0, 0);
                }
#pragma unroll
                for (int r = 0; r < 16; ++r) { p0[r] = __builtin_amdgcn_exp2f(p0[r]); p1[r] = __builtin_amdgcn_exp2f(p1[r]); }
                float st[8];
#pragma unroll
                for (int r = 0; r < 8; ++r) st[r] = (p0[r] + p1[r]) + (p0[r + 8] + p1[r + 8]);
                lrun += ((st[0] + st[1]) + (st[2] + st[3])) + ((st[4] + st[5]) + (st[6] + st[7]));
                u32x4 pw[4];
                pw[0] = (u32x4){pg8::cvt_pk_bf16(p0[0], p0[1]), pg8::cvt_pk_bf16(p0[2], p0[3]), pg8::cvt_pk_bf16(p0[4], p0[5]), pg8::cvt_pk_bf16(p0[6], p0[7])};
                pw[1] = (u32x4){pg8::cvt_pk_bf16(p0[8], p0[9]), pg8::cvt_pk_bf16(p0[10], p0[11]), pg8::cvt_pk_bf16(p0[12], p0[13]), pg8::cvt_pk_bf16(p0[14], p0[15])};
                pw[2] = (u32x4){pg8::cvt_pk_bf16(p1[0], p1[1]), pg8::cvt_pk_bf16(p1[2], p1[3]), pg8::cvt_pk_bf16(p1[4], p1[5]), pg8::cvt_pk_bf16(p1[6], p1[7])};
                pw[3] = (u32x4){pg8::cvt_pk_bf16(p1[8], p1[9]), pg8::cvt_pk_bf16(p1[10], p1[11]), pg8::cvt_pk_bf16(p1[12], p1[13]), pg8::cvt_pk_bf16(p1[14], p1[15])};
                const LAS unsigned char* vp = vp0 + jt * 8192;
#pragma unroll
                for (int ks = 0; ks < 4; ++ks) {
                    const bf16x8 pa = __builtin_bit_cast(bf16x8, pw[ks]);
                    { const s16x4 lo = vtr(vp + ks * 1024), hh = vtr(vp + ks * 1024 + 512);
                      const bf16x8 vf = {lo[0], lo[1], lo[2], lo[3], hh[0], hh[1], hh[2], hh[3]};
                      o0 = __builtin_amdgcn_mfma_f32_32x32x16_bf16(pa, vf, o0, 0, 0, 0); }
                    { const s16x4 lo = vtr(vp + 4096 + ks * 1024), hh = vtr(vp + 4096 + ks * 1024 + 512);
                      const bf16x8 vf = {lo[0], lo[1], lo[2], lo[3], hh[0], hh[1], hh[2], hh[3]};
                      o1 = __builtin_amdgcn_mfma_f32_32x32x16_bf16(pa, vf, o1, 0, 0, 0); }
                }
            }
            lrun += __shfl_xor(lrun, 32);
            if (hi == 0) wsf[32 + r32] = 1.0f / lrun;
            LDS_WAIT();
#pragma unroll
            for (int r = 0; r < 16; ++r) { const int qq = crow(r, hi); const float f = wsf[32 + qq] * 4.0f;
                const unsigned w = (unsigned)__builtin_amdgcn_cvt_pk_fp8_f32(o0[r] * f, o1[r] * f, 0, false); stg[qq * 64 + r32] = (unsigned char)(w & 0xffu); stg[qq * 64 + 32 + r32] = (unsigned char)((w >> 8) & 0xffu); }
            LDS_WAIT();
            unsigned char* ob = O + (rowb + (size_t)(128 * n + 32 * a)) * D + h * 64;
#pragma unroll
            for (int i = 0; i < 2; ++i) { const int row = i * 16 + (lane >> 2), ch = lane & 3; const u32x4 v = *(const LAS u32x4*)(stg + row * 64 + ch * 16); *(u32x4*)(ob + (size_t)row * D + ch * 16) = v; }
            LDS_WAIT();
        }
        __syncthreads();
    }
}
#endif

template <bool FINAL>
__device__ __forceinline__ void combine_phase(Frame& F, const bf16_t* H, const unsigned char* Y, bf16_t* HO, float* rs_out) {
    typedef float f32x2v __attribute__((ext_vector_type(2)));
    const int gw = F.bid * NWAVES + F.wave, NGW = F.G * NWAVES, lane = F.lane;
    const float* fn = IN_F(3); float* const outp = OUTP;
    for (int t = gw; t < T; t += NGW) {
        const u32x4* hp = (const u32x4*)(H + (size_t)t * D) + lane; const u32x2* y0 = (const u32x2*)(Y + (size_t)(2 * t) * D) + lane; const u32x2* y1 = (const u32x2*)(Y + (size_t)(2 * t + 1) * D) + lane;
        float v[16];
#pragma unroll
        for (int j = 0; j < 2; ++j) { const u32x4 a = __builtin_nontemporal_load(hp + 64 * j); const u32x2 b = __builtin_nontemporal_load(y0 + 64 * j), c = __builtin_nontemporal_load(y1 + 64 * j);
            const f32x2v b0 = __builtin_amdgcn_cvt_pk_f32_fp8((int)b.x, false), b1 = __builtin_amdgcn_cvt_pk_f32_fp8((int)b.x, true), b2 = __builtin_amdgcn_cvt_pk_f32_fp8((int)b.y, false), b3 = __builtin_amdgcn_cvt_pk_f32_fp8((int)b.y, true);
            const f32x2v c0 = __builtin_amdgcn_cvt_pk_f32_fp8((int)c.x, false), c1 = __builtin_amdgcn_cvt_pk_f32_fp8((int)c.x, true), c2 = __builtin_amdgcn_cvt_pk_f32_fp8((int)c.y, false), c3 = __builtin_amdgcn_cvt_pk_f32_fp8((int)c.y, true);
            const float ys = 0.0625f;
            v[8 * j + 0] = bf_lo(a.x) + (b0[0] + c0[0]) * ys; v[8 * j + 1] = bf_hi(a.x) + (b0[1] + c0[1]) * ys;
            v[8 * j + 2] = bf_lo(a.y) + (b1[0] + c1[0]) * ys; v[8 * j + 3] = bf_hi(a.y) + (b1[1] + c1[1]) * ys;
            v[8 * j + 4] = bf_lo(a.z) + (b2[0] + c2[0]) * ys; v[8 * j + 5] = bf_hi(a.z) + (b2[1] + c2[1]) * ys;
            v[8 * j + 6] = bf_lo(a.w) + (b3[0] + c3[0]) * ys; v[8 * j + 7] = bf_hi(a.w) + (b3[1] + c3[1]) * ys; }
        if constexpr (!FINAL) {
            u32x4 w[2]; float s = 0.f;
#pragma unroll
            for (int j = 0; j < 2; ++j) { w[j].x = pk2(v[8 * j], v[8 * j + 1]); w[j].y = pk2(v[8 * j + 2], v[8 * j + 3]); w[j].z = pk2(v[8 * j + 4], v[8 * j + 5]); w[j].w = pk2(v[8 * j + 6], v[8 * j + 7]);
                const float q0 = bf_lo(w[j].x), q1 = bf_hi(w[j].x), q2 = bf_lo(w[j].y), q3 = bf_hi(w[j].y), q4 = bf_lo(w[j].z), q5 = bf_hi(w[j].z), q6 = bf_lo(w[j].w), q7 = bf_hi(w[j].w);
                s += (q0 * q0 + q1 * q1) + (q2 * q2 + q3 * q3) + (q4 * q4 + q5 * q5) + (q6 * q6 + q7 * q7); }
            s = wave_sum(s);
            u32x4* op = (u32x4*)(HO + (size_t)t * D) + lane; op[0] = w[0]; op[64] = w[1];
            if (lane == 0) rs_out[t] = 1.0f / sqrtf(s * (1.0f / D) + EPS);
        } else {
            float s = 0.f;
#pragma unroll
            for (int j = 0; j < 16; ++j) s += v[j] * v[j];
            s = wave_sum(s);
            const float r = 1.0f / sqrtf(s * (1.0f / D) + EPS);
#pragma unroll
            for (int j = 0; j < 2; ++j) { const int c0 = 512 * j + 8 * lane; const f32x4 g0 = *(const f32x4*)(fn + c0), g1 = *(const f32x4*)(fn + c0 + 4);
                float* op = outp + (size_t)t * D + c0;
                __builtin_nontemporal_store((f32x4){v[8 * j] * r * g0[0], v[8 * j + 1] * r * g0[1], v[8 * j + 2] * r * g0[2], v[8 * j + 3] * r * g0[3]}, (f32x4*)op);
                __builtin_nontemporal_store((f32x4){v[8 * j + 4] * r * g1[0], v[8 * j + 5] * r * g1[1], v[8 * j + 6] * r * g1[2], v[8 * j + 7] * r * g1[3]}, (f32x4*)(op + 4)); }
        }
    }
}
__device__ __forceinline__ void conv_phase(Frame& F) {
    const bf16_t* BG = (const bf16_t*)(WSP + WS_BG); const bf16_t* Z = (const bf16_t*)(WSP + WS_Z); unsigned char* A4 = WSP + WS_A4;   const float* cw = IN_F(11);
    const int c0 = (F.tid & 127) * 8;
    float w0[8], w1[8], w2[8];
#pragma unroll
    for (int j = 0; j < 8; ++j) { w0[j] = cw[c0 + j]; w1[j] = cw[D + c0 + j]; w2[j] = cw[2 * D + c0 + j]; }
    for (int t = F.bid * 4 + (F.tid >> 7); t < T; t += F.G * 4) {
        const int pos = t & (SEQ - 1);
        const u32x4 b = *(const u32x4*)(BG + (size_t)t * D + c0), z2 = *(const u32x4*)(Z + (size_t)t * D + c0);
        u32x4 z1 = {0u, 0u, 0u, 0u}, z0 = {0u, 0u, 0u, 0u};
        if (pos >= 1) z1 = *(const u32x4*)(Z + (size_t)(t - 1) * D + c0);
        if (pos >= 2) z0 = *(const u32x4*)(Z + (size_t)(t - 2) * D + c0);
        float r[8];
#define CV(j, comp, part) r[j] = part(b.comp) * (w0[j] * part(z0.comp) + w1[j] * part(z1.comp) + w2[j] * part(z2.comp))
        CV(0, x, bf_lo); CV(1, x, bf_hi); CV(2, y, bf_lo); CV(3, y, bf_hi); CV(4, z, bf_lo); CV(5, z, bf_hi); CV(6, w, bf_lo); CV(7, w, bf_hi);
#undef CV
        u32x2 o; o.x = pk4_fp8(r[0] * 4.f, r[1] * 4.f, r[2] * 4.f, r[3] * 4.f); o.y = pk4_fp8(r[4] * 4.f, r[5] * 4.f, r[6] * 4.f, r[7] * 4.f);
        *(u32x2*)(A4 + (size_t)t * D + c0) = o;
    }
}

constexpr int N_PHASES = 15;
#ifndef PH_MASK
#define PH_MASK 0x7fff
#endif
#ifndef REPEAT_MASK
#define REPEAT_MASK 0
#endif
__global__ void __launch_bounds__(NTHR, 2) mk_fwd(Args args) {
    __shared__ __attribute__((aligned(16))) unsigned char lds_raw[LDS_BYTES];
    Frame F0;
    F0.lds = (LAS unsigned char*)lds_raw;
    F0.tid = threadIdx.x; F0.lane = F0.tid & 63; F0.wave = __builtin_amdgcn_readfirstlane(F0.tid >> 6);
    F0.G = gridDim.x; F0.bid = blockIdx.x;
    const Frame& F = F0;
    if (F.tid < (LDSCTL_END - LDSCTL_OFF) / 4) ((LAS unsigned*)(F.lds + LDSCTL_OFF))[F.tid] = 0u;
    if (F.tid == 0) {
#pragma unroll
        for (int i = 0; i < 19; ++i) { ((volatile LAS unsigned long long*)(F.lds + PT_OFF))[i] = (unsigned long long)args.in[i]; }
        ((volatile LAS unsigned long long*)(F.lds + PT_OFF))[19] = (unsigned long long)args.ws;
        ((volatile LAS unsigned long long*)(F.lds + PT_OFF))[20] = (unsigned long long)args.out;
    }
    __syncthreads();
    if (MK_N_LAUNCHES != N_PHASES) (void)xcd_barrier_post((unsigned*)(args.ws + WS_CTL) + CW_BAR, (volatile LAS unsigned*)(F.lds + MISC_OFF) + 8);
    const int lo = args.ph_lo, hi = args.ph_hi;
#pragma unroll 1
    for (int ph2 = 2 * lo; ph2 < 2 * hi; ++ph2) {
        const int ph = ph2 >> 1;
        if ((ph2 & 1) && !((REPEAT_MASK >> (ph >= 11 ? ph - 7 : ph)) & 1)) continue;
        Frame F = F0;
        int wv = F0.wave; asm volatile("" : "+s"(wv)); asm volatile("" : "+s"(F.G), "+s"(F.bid));
        unsigned ones = ~0u; asm volatile("" : "+s"(ones));
        F.wave = wv; F.lane = (int)__builtin_amdgcn_mbcnt_hi(ones, __builtin_amdgcn_mbcnt_lo(ones, 0u));
        F.tid = F.wave * 64 + F.lane;
        const int layer = ph >= 11 ? 1 : 0;
        const int k = ph >= 11 ? ph - 7 : ph;
        if ((PH_MASK >> k) & 1) {
          {
            switch (k) {
            case 0: p0_prologue(F); break;
            case 1: { PolQKV P; P.init(WSP + WS_XB, WSP + WS_WQKV, D, QKVD, F.G, F.bid); P.O = (bf16_t*)(WSP + WS_QKV); P.side = (const float*)(WSP + WS_RS0); P.bias = IN_F(6); pg8::gemm_phase(F.lds + RING_OFF, F.lds, F.tid, P);
                if (F.bid >= (5 * 128) % F.G && (5 * 128) % F.G != 0) conv_steal(F, 24, NITEMS, false); } break;
            case 2: attn_phase(F); conv_steal(F, 64, Q_O, true); break;
            case 3: { PolOproj P; P.init(WSP + WS_O, WSP + WS_WO, D / 2, D, F.G, F.bid); P.scale_w = 0x79797979; P.scale_a = 0x7d7d7d7d;   P.O = (bf16_t*)(WSP + WS_HA); P.xb = (const bf16_t*)(WSP + WS_XB); P.bias = IN_F(8); P.ssq = (float*)(WSP + WS_SSQ); P.H8 = WSP + WS_H8; pg8::gemm_phase(F.lds + RING_OFF, F.lds, F.tid, P); } break;
            case 4: { PolRoute P; P.init(WSP + WS_HA, WSP + WS_WR + (size_t)layer * 256 * 1024 * 2, D, 256, F.G, F.bid); P.lds = F.lds + RING_OFF; P.ssq = (const float*)(WSP + WS_SSQ); P.bg = IN_F(14) + layer * 4; P.be = IN_F(16) + layer * 32;
                P.ecount = (unsigned*)(WSP + WS_CTL) + CW_ECNT + layer * 64; P.elist = (int*)(WSP + WS_ELIST); P.gate = (float*)(WSP + WS_GATE); P.ascale = (float*)(WSP + WS_ASCALE); P.tid = F.tid; pg8::gemm_phase(F.lds + RING_OFF, F.lds, F.tid, P);
                if (F.bid >= 128) conv_steal(F, 32, NITEMS, false);
                conv_steal(F, 64, layer == 0 ? Q_GU0 : Q_GU1, true); } break;
            case 5: { moe_build_etab(F, (const unsigned*)(WSP + WS_CTL) + CW_ECNT + layer * 64);
                PolMoe1 P; P.Abase = (const char*)(WSP + WS_H8); P.W = (const char*)(WSP + WS_WGU) + (size_t)layer * 32 * 1024 * D; P.K = D / 2; P.G = F.G; P.c = F.bid; P.wstride = (size_t)1024 * D; P.scale_w = 0x79797979; P.scale_a = 0x7f7f7f7f;
                P.elist = (const int*)(WSP + WS_ELIST); P.etab = (LAS int*)(F.lds + ETAB_OFF); P.ACT = WSP + WS_ACT; P.ascale = (const float*)(WSP + WS_ASCALE); pg8::gemm_phase(F.lds + RING_OFF, F.lds, F.tid, P);
                { const int nwg = ((LAS int*)(F.lds + ETAB_OFF))[64] * 4, r = nwg % F.G; if (r != 0 && F.bid >= r) conv_steal(F, 12, NITEMS, false); }
                conv_steal(F, 64, layer == 0 ? Q_L0 : Q_L1, true); } break;
            case 6: {
#if MK_N_LAUNCHES != 1
                moe_build_etab(F, (const unsigned*)(WSP + WS_CTL) + CW_ECNT + layer * 64);
#endif
                PolMoe2 P; P.Abase = (const char*)(WSP + WS_ACT); P.W = (const char*)(WSP + WS_WDN) + (size_t)layer * 32 * D * FF; P.K = FF / 2; P.G = F.G; P.c = F.bid; P.wstride = (size_t)D * FF; P.scale_w = 0x7a7a7a7a; P.scale_a = 0x7d7d7d7d;
                P.elist = (const int*)(WSP + WS_ELIST); P.etab = (LAS int*)(F.lds + ETAB_OFF); P.Y = WSP + WS_Y; P.gate = (const float*)(WSP + WS_GATE); pg8::gemm_phase(F.lds + RING_OFF, F.lds, F.tid, P);
                if (layer == 0) { const int nwg = ((LAS int*)(F.lds + ETAB_OFF))[64] * 4, r = nwg % F.G; if (r != 0 && F.bid >= r) conv_steal(F, 8, NITEMS, false); } } break;
            case 7: if (layer == 0) { combine_phase<false>(F, (const bf16_t*)(WSP + WS_HA), (const unsigned char*)(WSP + WS_Y), (bf16_t*)(WSP + WS_HB), (float*)(WSP + WS_RS2)); conv_steal(F, 64, Q_IN, true); }
                    else combine_phase<true>(F, (const bf16_t*)(WSP + WS_HA), (const unsigned char*)(WSP + WS_Y), nullptr, nullptr);
                    break;
            case 8: { PolConvIn P; P.init(WSP + WS_HB, WSP + WS_WIN, D, 3 * D, F.G, F.bid); P.BG = (bf16_t*)(WSP + WS_BG); P.Z = (bf16_t*)(WSP + WS_Z); P.side = (const float*)(WSP + WS_RS2); pg8::gemm_phase(F.lds + RING_OFF, F.lds, F.tid, P); } break;
            case 9: conv_phase(F); conv_steal(F, 64, Q_OUT, true); break;
            case 10: { PolConvOut P; P.init(WSP + WS_A4, WSP + WS_WOUT, D / 2, D, F.G, F.bid); P.scale_w = 0x79797979; P.scale_a = 0x7d7d7d7d;   P.O = (bf16_t*)(WSP + WS_HA); P.H = (const bf16_t*)(WSP + WS_HB); P.ssq = (float*)(WSP + WS_SSQ); P.H8 = WSP + WS_H8; pg8::gemm_phase(F.lds + RING_OFF, F.lds, F.tid, P); } break;
            default: break;
            }
          }
        }
        if ((ph + 1 < hi) || (!(ph2 & 1) && ((REPEAT_MASK >> k) & 1))) { XcdBarrier bar; bar.bar = (unsigned*)(WSP + WS_CTL) + CW_BAR; bar.x = xb_xcc_id(); bar.st = (volatile LAS unsigned*)(F.lds + MISC_OFF) + 8; xcd_barrier(bar);
#ifdef PROBE_DOUBLE_BAR
            xcd_barrier(bar);
#endif
        }
    }
}

extern "C" void kernel_launch(void* const* d_in, const int* in_sizes, int n_in, void* d_out, int out_size, void* d_ws, size_t ws_size, hipStream_t stream) {
    static int grid = 0;
    if (grid == 0) {
        if (n_in != 19 || in_sizes[0] != T * D || out_size != T * D || ws_size < WS_END) { fprintf(stderr, "kernel_launch: unexpected shapes (n_in %d, in0 %d, out %d, ws %zu); nothing launched\n", n_in, n_in > 0 ? in_sizes[0] : -1, out_size, ws_size); grid = -1; return; }
        int dev = 0, cus = 0;
        if (hipGetDevice(&dev) != hipSuccess || hipDeviceGetAttribute(&cus, hipDeviceAttributeMultiprocessorCount, dev) != hipSuccess) { grid = -1; return; }
        int per_cu = 0;
        if (hipOccupancyMaxActiveBlocksPerMultiprocessor(&per_cu, (const void*)mk_fwd, NTHR, 0) != hipSuccess || per_cu < 1) fprintf(stderr, "kernel_launch: occupancy query reports %d workgroups per CU\n", per_cu);
        (void)hipGetLastError();
        grid = cus;
    }
    if (grid < 0) return;
    if (hipMemsetAsync((char*)d_ws + WS_CTL, 0, CTL_ZERO_BYTES, stream) != hipSuccess) { fprintf(stderr, "kernel_launch: hipMemsetAsync failed\n"); return; }
    Args a{};
    for (int i = 0; i < 19; ++i) a.in[i] = (const float*)d_in[i];
    a.out = (float*)d_out; a.ws = (unsigned char*)d_ws;
#if MK_N_LAUNCHES == 1
    a.ph_lo = 0; a.ph_hi = N_PHASES; a.li = 0;
    hipLaunchKernelGGL(mk_fwd, dim3(grid), dim3(NTHR), 0, stream, a);
#else
    for (int li = 0; li < N_PHASES; ++li) { a.ph_lo = li; a.ph_hi = li + 1; a.li = 0; hipLaunchKernelGGL(mk_fwd, dim3(grid), dim3(NTHR), 0, stream, a); }
#endif
    const hipError_t le = hipPeekAtLastError();
    if (le != hipSuccess) fprintf(stderr, "kernel_launch: launch failed: %s\n", hipGetErrorName(le));
}
```

```cpp
#include <hip/hip_runtime.h>
#include <cstdio>
#include <cstdint>

#define LAS __attribute__((address_space(3)))
#define GAS __attribute__((address_space(1)))
typedef unsigned short bf16_t;
typedef short bf16x8 __attribute__((ext_vector_type(8)));
typedef short s16x4 __attribute__((ext_vector_type(4)));
typedef float f32x4 __attribute__((ext_vector_type(4)));
typedef float f32x16 __attribute__((ext_vector_type(16)));
typedef unsigned u32x4 __attribute__((ext_vector_type(4)));
typedef unsigned u32x2 __attribute__((ext_vector_type(2)));
typedef int v8i __attribute__((ext_vector_type(8)));

#ifndef MK_N_LAUNCHES
#define MK_N_LAUNCHES 1
#endif
#ifndef ATTN_NAIVE
#define ATTN_NAIVE 0
#endif

constexpr int T = 32768, D = 1024, SEQ = 4096, QKVD = 1280, NH = 16, HD = 64;
constexpr int NE = 32, FF = 512, NA = 2 * T;
constexpr float EPS = 1e-5f, LOG2E = 1.4426950408889634f;
constexpr float QSCALE = 0.125f * LOG2E;
constexpr int NWAVES = 8, NTHR = 512;

constexpr size_t MiB = 1u << 20;
constexpr size_t WS_CTL = 0, CTL_ZERO_BYTES = 128 * 1024;
constexpr size_t WS_WQKV = 2 * MiB, WS_WO = 5 * MiB, WS_WIN = 7 * MiB, WS_WOUT = 13 * MiB, WS_WR = 15 * MiB;
constexpr size_t WS_RS0 = 16 * MiB, WS_RS2 = WS_RS0 + 128 * 1024, WS_ASCALE = WS_RS2 + 128 * 1024, WS_GATE = WS_ASCALE + 256 * 1024;
constexpr size_t WS_SSQ = 21 * MiB;
constexpr size_t WS_WGU = 32 * MiB, WS_WDN = 160 * MiB;
constexpr size_t WS_XB = 224 * MiB, WS_QKV = 288 * MiB, WS_O = 368 * MiB, WS_HA = 432 * MiB, WS_HB = 496 * MiB, WS_ACT = 560 * MiB, WS_Y = 624 * MiB, WS_H8 = 752 * MiB, WS_ELIST = 784 * MiB, WS_END = 800 * MiB;
constexpr size_t WS_BG = WS_XB, WS_Z = WS_QKV, WS_A4 = WS_O;
constexpr int CW_BAR = 4096, CW_ECNT = 16384;

constexpr int PT_OFF = 0  , MISC_OFF = 256  , LDSCTL_OFF = 256, LDSCTL_END = 512, ETAB_OFF = 512  , LISTS_OFF = 2048  , RING_OFF = 14336, RING_BYTES = 131072, LDS_BYTES = 147456;

__device__ __forceinline__ unsigned f2bf(float f) { unsigned u = __builtin_bit_cast(unsigned, f); return (u + 0x7fffu + ((u >> 16) & 1u)) >> 16; }
__device__ __forceinline__ unsigned pk2(float lo, float hi) { return f2bf(lo) | (f2bf(hi) << 16); }
__device__ __forceinline__ float bf_lo(unsigned w) { return __builtin_bit_cast(float, w << 16); }
__device__ __forceinline__ float bf_hi(unsigned w) { return __builtin_bit_cast(float, w & 0xffff0000u); }
__device__ __forceinline__ float bf2f(bf16_t h) { return __builtin_bit_cast(float, (unsigned)h << 16); }
__device__ __forceinline__ float wave_sum(float v) {
#pragma unroll
    for (int o = 1; o < 64; o <<= 1) v += __shfl_xor(v, o);
    return v;
}
__device__ __forceinline__ unsigned pk4_fp8(float a, float b, float c, float d) { int p = __builtin_amdgcn_cvt_pk_fp8_f32(a, b, 0, false); p = __builtin_amdgcn_cvt_pk_fp8_f32(c, d, p, true); return (unsigned)p; }
#define LDS_WAIT() asm volatile("s_waitcnt lgkmcnt(0)" ::: "memory")
#define VM_WAIT() asm volatile("s_waitcnt vmcnt(0)" ::: "memory")

namespace pg8 {
constexpr int BM = 256, BK = 64, HALF = 128, HTB = HALF * BK * 2, STAGE_BYTES = 8 * HTB, NXCD = 8, WGM = 8;
__host__ __device__ __forceinline__ int lds_byte(int r, int c) { const int st = (r >> 4) * 2 + (c >> 5), rr = r & 15, cc = c & 31, ob = rr * 64 + cc * 2; return st * 1024 + (ob ^ (((ob >> 9) & 1) << 5)); }
__host__ __device__ __forceinline__ void stage_rc(int b, int& R, int& C) { const int st = b / 1024, sb = b % 1024, swz = sb ^ (((sb >> 9) & 1) << 5); R = (st >> 1) * 16 + swz / 64; C = (st & 1) * 32 + (swz % 64) / 2; }
__host__ __device__ __forceinline__ int perm32(int rho) { const int n = rho >> 4, i = rho & 15; return 8 * (i >> 2) + 4 * n + (i & 3); }
__device__ __forceinline__ unsigned cvt_pk_bf16(float lo, float hi) { unsigned r; asm volatile("v_cvt_pk_bf16_f32 %0, %1, %2" : "=v"(r) : "v"(lo), "v"(hi)); return r; }

struct Unit { int pm, pn, nrows; const char* bptr; const int* list; };

__device__ __forceinline__ int xcd_remap(int L, int nwg) { const int q = nwg / NXCD, r = nwg % NXCD, xcd = L % NXCD, off = L / NXCD; return (xcd < r ? xcd * (q + 1) : r * (q + 1) + (xcd - r) * q) + off; }

typedef f32x4 Acc[2][2][4][2];

template <class P>
__device__ __forceinline__ void gemm_phase(LAS unsigned char* lds, LAS unsigned char* ctl, const int tid, const P& p) {
    const int wid = __builtin_amdgcn_readfirstlane(tid >> 6), lane = tid & 63, wr = wid >> 2, wc = wid & 3, fr = lane & 15, fq = lane >> 4;
    const int K = p.K, nt = K / BK;
    unsigned voffB[2];
#pragma unroll
    for (int i = 0; i < 2; ++i) { int R, C; stage_rc(tid * 16 + i * 8192, R, C);
        const int Rb = P::WIDE ? (64 * (R >> 5) + 16 * ((R >> 2) & 3) + 4 * ((R >> 4) & 1) + (R & 3)) : ((R & ~31) + perm32(R & 31)); voffB[i] = (unsigned)(Rb * K + C) * 2u; }
    const size_t kstep = (size_t)(BK * 2);
    const size_t hstep = (size_t)(P::WIDE ? 8 : HALF) * K * 2;
    const unsigned ldsw = (unsigned)wid * 1024u;
    const int aoff = lds_byte(wr * 64 + fr, fq * 8), boff = lds_byte(wc * 32 + fr, fq * 8);
    LAS int* const lists = (LAS int*)(ctl + LISTS_OFF);
#define PG8_SA(b, h) (((b) * 2 + (h)) * HTB)
#define PG8_SB(b, h) ((4 + (b) * 2 + (h)) * HTB)
#define PG8_STAGE(bufoff, gbase, voff) do { _Pragma("unroll") for (int _i = 0; _i < 2; ++_i) \
        __builtin_amdgcn_global_load_lds((const unsigned*)((const char*)(gbase) + (voff)[_i]), (LAS unsigned*)(lds + (bufoff) + ldsw + _i * 8192), 16, 0, 0); } while (0)
#define PG8_LDA(dst, b, h) do { _Pragma("unroll") for (int m = 0; m < 4; ++m) _Pragma("unroll") for (int k = 0; k < 2; ++k) dst[m][k] = *(const LAS bf16x8*)(lds + PG8_SA(b, h) + aoff + m * 2048 + k * 1024); } while (0)
#define PG8_LDB(dst, b, h) do { _Pragma("unroll") for (int n = 0; n < 2; ++n) _Pragma("unroll") for (int k = 0; k < 2; ++k) dst[n][k] = *(const LAS bf16x8*)(lds + PG8_SB(b, h) + boff + n * 2048 + k * 1024); } while (0)
#define PG8_LDA8(dst, b, h) do { _Pragma("unroll") for (int m = 0; m < 4; ++m) { const u32x4 lo_ = *(const LAS u32x4*)(lds + PG8_SA(b, h) + aoff + m * 2048), hi_ = *(const LAS u32x4*)(lds + PG8_SA(b, h) + aoff + m * 2048 + 1024); \
        dst[m] = (v8i){(int)lo_.x, (int)lo_.y, (int)lo_.z, (int)lo_.w, (int)hi_.x, (int)hi_.y, (int)hi_.z, (int)hi_.w}; } } while (0)
#define PG8_LDB8(dst, b, h) do { _Pragma("unroll") for (int n = 0; n < 2; ++n) { const u32x4 lo_ = *(const LAS u32x4*)(lds + PG8_SB(b, h) + boff + n * 2048), hi_ = *(const LAS u32x4*)(lds + PG8_SB(b, h) + boff + n * 2048 + 1024); \
        dst[n] = (v8i){(int)lo_.x, (int)lo_.y, (int)lo_.z, (int)lo_.w, (int)hi_.x, (int)hi_.y, (int)hi_.z, (int)hi_.w}; } } while (0)
#define PG8_MMA8(ai, bj, At, Bt) do { __builtin_amdgcn_s_setprio(1); _Pragma("unroll") for (int m = 0; m < 4; ++m) _Pragma("unroll") for (int n = 0; n < 2; ++n) \
        acc[ai][bj][m][n] = __builtin_amdgcn_mfma_scale_f32_16x16x128_f8f6f4(Bt[n], At[m], acc[ai][bj][m][n], 0, 0, 0, p.scale_w, 0, p.scale_a); __builtin_amdgcn_s_setprio(0); } while (0)
#define PG8_MMA(ai, bj, At, Bt) do { __builtin_amdgcn_s_setprio(1); _Pragma("unroll") for (int m = 0; m < 4; ++m) _Pragma("unroll") for (int n = 0; n < 2; ++n) _Pragma("unroll") for (int k = 0; k < 2; ++k) \
        acc[ai][bj][m][n] = __builtin_amdgcn_mfma_f32_16x16x32_bf16(Bt[n][k], At[m][k], acc[ai][bj][m][n], 0, 0, 0); __builtin_amdgcn_s_setprio(0); } while (0)
#define PG8_WAIT_V(n) asm volatile("s_waitcnt vmcnt(" #n ")" ::: "memory")
#define PG8_WAIT_L(n) asm volatile("s_waitcnt lgkmcnt(" #n ")" ::: "memory")
#define PG8_WAIT_VR() do { if (EO > 0 && relax) asm volatile("s_waitcnt vmcnt(%0)" :: "n"(8 + EO) : "memory"); else PG8_WAIT_V(8); } while (0)
#define PG8_BAR __builtin_amdgcn_s_barrier()
#define PG8_SCHED __builtin_amdgcn_sched_barrier(0)
#define PG8_ZERO_ACC() do { _Pragma("unroll") for (int a = 0; a < 2; ++a) _Pragma("unroll") for (int b = 0; b < 2; ++b) _Pragma("unroll") for (int m = 0; m < 4; ++m) _Pragma("unroll") for (int n = 0; n < 2; ++n) acc[a][b][m][n] = (f32x4){0.f, 0.f, 0.f, 0.f}; } while (0)
    constexpr int EO = P::EPI_OPS;
    Unit cur, nxt; int ui = 0;
    if (!p.next(0, cur)) return;
    if constexpr (P::SIDE) {
        if (wid == 0) __builtin_amdgcn_global_load_lds((const unsigned*)(p.side + (size_t)cur.pm * 256 + lane * 4), (LAS unsigned*)(ctl + LISTS_OFF), 16, 0, 0);
        PG8_WAIT_V(0); PG8_BAR; asm volatile("" ::: "memory");
    }
    if constexpr (P::GATHER) {
        if (wid < 4) __builtin_amdgcn_global_load_lds((const unsigned*)(cur.list + (wid * 64 + lane) * 4), (LAS unsigned*)(ctl + LISTS_OFF + wid * 1024), 16, 0, 0);
        PG8_WAIT_V(0); PG8_BAR; asm volatile("" ::: "memory");
    }
    Acc acc; PG8_ZERO_ACC();
    bf16x8 At[4][2], B0[2][2], B1[2][2];
    v8i At8[4], B08[2], B18[2];
    unsigned voffA[2][2];
    p.a_off(cur, lists, tid, voffA);
    const char* const cA = p.Abase; const char* cB = cur.bptr;
    PG8_STAGE(PG8_SB(0, 0), cB, voffB); PG8_STAGE(PG8_SB(0, 1), cB + hstep, voffB); PG8_STAGE(PG8_SA(0, 0), cA, voffA[0]); PG8_STAGE(PG8_SA(0, 1), cA, voffA[1]);
    if (wr == 1) PG8_BAR;
    PG8_WAIT_V(2); PG8_BAR;
    PG8_STAGE(PG8_SB(1, 0), cB + kstep, voffB); PG8_STAGE(PG8_SA(1, 0), cA + kstep, voffA[0]); PG8_STAGE(PG8_SB(1, 1), cB + hstep + kstep, voffB);
    PG8_WAIT_V(6); PG8_BAR;
    if constexpr (EO > 0) PG8_STAGE(PG8_SA(1, 1), cA + kstep, voffA[1]);
    for (;;) {
        const bool has_next = p.next(ui + 1, nxt);
        if constexpr (P::GATHER) {
            if (has_next && wid < 4) __builtin_amdgcn_global_load_lds((const unsigned*)(nxt.list + (wid * 64 + lane) * 4), (LAS unsigned*)(ctl + LISTS_OFF + ((ui + 1) % 3) * 4096 + wid * 1024), 16, 0, 0);
        }
        if constexpr (P::SIDE) { if (has_next && wid == 0) __builtin_amdgcn_global_load_lds((const unsigned*)(p.side + (size_t)nxt.pm * 256 + lane * 4), (LAS unsigned*)(ctl + LISTS_OFF + ((ui + 1) % 3) * 4096), 16, 0, 0); }
        const char* nB = has_next ? nxt.bptr : cB;
#pragma unroll 1
        for (int t = 0; t < nt; t += 2) {
            const bool last = (t == nt - 2);
            const bool relax = (EO > 0) && (t == 0) && (ui > 0);
            const char* a1 = cA + (size_t)(t + 1) * kstep;
            const char* a2 = last ? cA : cA + (size_t)(t + 2) * kstep; const char* b2 = last ? nB : cB + (size_t)(t + 2) * kstep;
            const char* a3 = a2 + kstep; const char* b3 = b2 + kstep;
            if constexpr (!P::FP8) {
            PG8_LDB(B0, 0, 0); PG8_LDB(B1, 0, 1); PG8_SCHED; PG8_LDA(At, 0, 0); if (EO == 0 || t != 0) PG8_STAGE(PG8_SA(1, 1), a1, voffA[1]);
            if (last && has_next) p.a_off(nxt, lists + ((ui + 1) % 3) * 1024, tid, voffA);
            PG8_WAIT_VR(); PG8_WAIT_L(0); PG8_BAR; PG8_MMA(0, 0, At, B0); PG8_MMA(0, 1, At, B1); PG8_BAR; PG8_SCHED;
            PG8_LDA(At, 0, 1); PG8_STAGE(PG8_SB(0, 0), b2, voffB); PG8_STAGE(PG8_SB(0, 1), b2 + hstep, voffB); PG8_STAGE(PG8_SA(0, 0), a2, voffA[0]);
            PG8_WAIT_VR(); PG8_WAIT_L(0); PG8_BAR; PG8_MMA(1, 0, At, B0); PG8_MMA(1, 1, At, B1); PG8_BAR; PG8_SCHED;
            PG8_LDB(B0, 1, 0); PG8_LDB(B1, 1, 1); PG8_SCHED; PG8_LDA(At, 1, 0); PG8_STAGE(PG8_SA(0, 1), a2, voffA[1]);
            PG8_WAIT_VR(); PG8_WAIT_L(0); PG8_BAR; PG8_MMA(0, 0, At, B0); PG8_MMA(0, 1, At, B1); PG8_BAR; PG8_SCHED;
            PG8_LDA(At, 1, 1); PG8_STAGE(PG8_SB(1, 0), b3, voffB); PG8_STAGE(PG8_SB(1, 1), b3 + hstep, voffB); PG8_STAGE(PG8_SA(1, 0), a3, voffA[0]);
            PG8_WAIT_V(8); PG8_WAIT_L(0); PG8_BAR; PG8_MMA(1, 0, At, B0); PG8_MMA(1, 1, At, B1); PG8_BAR; PG8_SCHED;
            } else {
            PG8_LDB8(B08, 0, 0); PG8_LDB8(B18, 0, 1); PG8_SCHED; PG8_LDA8(At8, 0, 0); PG8_STAGE(PG8_SA(1, 1), a1, voffA[1]);
            if (last && has_next) p.a_off(nxt, lists + ((ui + 1) % 3) * 1024, tid, voffA);
            PG8_WAIT_V(8); PG8_WAIT_L(0); PG8_BAR; PG8_MMA8(0, 0, At8, B08); PG8_MMA8(0, 1, At8, B18); PG8_BAR; PG8_SCHED;
            PG8_LDA8(At8, 0, 1); PG8_STAGE(PG8_SB(0, 0), b2, voffB); PG8_STAGE(PG8_SB(0, 1), b2 + hstep, voffB); PG8_STAGE(PG8_SA(0, 0), a2, voffA[0]);
            PG8_WAIT_V(8); PG8_WAIT_L(0); PG8_BAR; PG8_MMA8(1, 0, At8, B08); PG8_MMA8(1, 1, At8, B18); PG8_BAR; PG8_SCHED;
            PG8_LDB8(B08, 1, 0); PG8_LDB8(B18, 1, 1); PG8_SCHED; PG8_LDA8(At8, 1, 0); PG8_STAGE(PG8_SA(0, 1), a2, voffA[1]);
            PG8_WAIT_V(8); PG8_WAIT_L(0); PG8_BAR; PG8_MMA8(0, 0, At8, B08); PG8_MMA8(0, 1, At8, B18); PG8_BAR; PG8_SCHED;
            PG8_LDA8(At8, 1, 1); PG8_STAGE(PG8_SB(1, 0), b3, voffB); PG8_STAGE(PG8_SB(1, 1), b3 + hstep, voffB); PG8_STAGE(PG8_SA(1, 0), a3, voffA[0]);
            PG8_WAIT_V(8); PG8_WAIT_L(0); PG8_BAR; PG8_MMA8(1, 0, At8, B08); PG8_MMA8(1, 1, At8, B18); PG8_BAR; PG8_SCHED;
            }
        }
        if (wr == 0) PG8_BAR;
        if constexpr (EO > 0) { if (has_next) PG8_STAGE(PG8_SA(1, 1), cA + kstep, voffA[1]); asm volatile("" ::: "memory"); }
        if constexpr (!P::AFTER_DRAIN) p.epi(acc, cur, lists + (ui % 3) * 1024, wr, wc, fr, fq);
        asm volatile("" ::: "memory");
        if (!has_next) break;
        PG8_ZERO_ACC();
        cur = nxt; cB = nB; ++ui;
        if (wr == 1) PG8_BAR;
    }
    PG8_WAIT_V(0);
    PG8_BAR;
    asm volatile("" ::: "memory");
    if constexpr (P::AFTER_DRAIN) p.epi(acc, cur, lists + (ui % 3) * 1024, wr, wc, fr, fq);
#undef PG8_SA
#undef PG8_SB
#undef PG8_STAGE
#undef PG8_LDA
#undef PG8_LDB
#undef PG8_MMA
#undef PG8_MMA8
#undef PG8_LDA8
#undef PG8_LDB8
#undef PG8_WAIT_V
#undef PG8_WAIT_L
#undef PG8_WAIT_VR
#undef PG8_BAR
#undef PG8_SCHED
#undef PG8_ZERO_ACC
}
}

#define XB_TMO      128
#define XB_XCNT(j)  (256  + 64 * (j))
#define XB_XSUB(j)  (1280 + 64 * (j))
#define XB_XGEN(j)  (2304 + 64 * (j))
#define XB_TOP      3328
#define XB_TOPGEN   3392
#define XCD_BAR_WORDS 3456
#define XB_SPIN_CAP (1u << 22)
__device__ __forceinline__ unsigned xb_ld(unsigned* p)              { return __hip_atomic_load(p, __ATOMIC_RELAXED, __HIP_MEMORY_SCOPE_AGENT); }
__device__ __forceinline__ unsigned xb_add(unsigned* p, unsigned v) { return __hip_atomic_fetch_add(p, v, __ATOMIC_RELAXED, __HIP_MEMORY_SCOPE_AGENT); }
__device__ __forceinline__ unsigned xb_xcc_id() { return (unsigned)__builtin_amdgcn_s_getreg((3 << 11) | 20) & 0xFu; }
#define XB_SPIN(cond, bar) do { unsigned _sp = 0; while (cond) { __builtin_amdgcn_s_sleep(1); \
    if ((++_sp & 255u) == 0u) { if (xb_ld(&(bar)[XB_TMO])) break; if (_sp > XB_SPIN_CAP) { atomicAdd(&(bar)[XB_TMO], 1u); break; } } } } while (0)
struct XcdBarrier { unsigned* bar; unsigned x; volatile LAS unsigned* st; };
__device__ __forceinline__ XcdBarrier xcd_barrier_post(unsigned* bar, volatile LAS unsigned* st) {
    XcdBarrier b; b.bar = bar; b.x = xb_xcc_id(); b.st = st;
    if (threadIdx.x == 0) (void)xb_add(&bar[XB_XCNT(b.x)], 1u);
    return b;
}
__device__ __forceinline__ void xcd_barrier_complete(unsigned* bar, unsigned x, unsigned& nloc, unsigned& nx) {
    const unsigned G = gridDim.x * gridDim.y * gridDim.z;
    unsigned sum, cnt, mine, sp = 0u;
    for (;;) {
        sum = 0u; cnt = 0u; mine = 0u;
#pragma unroll
        for (unsigned j = 0; j < 16; ++j) { const unsigned c = xb_ld(&bar[XB_XCNT(j)]); sum += c; cnt += (c > 0u) ? 1u : 0u; mine = (j == x) ? c : mine; }
        if (sum == G) break;
        __builtin_amdgcn_s_sleep(1);
        if ((++sp & 255u) == 0u) { if (xb_ld(&bar[XB_TMO])) break; if (sp > XB_SPIN_CAP) { atomicAdd(&bar[XB_TMO], 1u); break; } }
    }
    nloc = mine > 0u ? mine : 1u; nx = cnt > 0u ? cnt : 1u;
}
__device__ __forceinline__ void xcd_barrier(const XcdBarrier& b) {
    asm volatile("s_waitcnt vmcnt(0)" ::: "memory");
    __syncthreads();
    if (threadIdx.x == 0) {
        unsigned* bar = b.bar;
        __builtin_amdgcn_s_waitcnt(0);
        unsigned nloc = b.st[0], nx = b.st[1];
        if (nloc == 0u) { xcd_barrier_complete(bar, b.x, nloc, nx); b.st[0] = nloc; b.st[1] = nx; }
        const unsigned old = xb_add(&bar[XB_XSUB(b.x)], 1u);
        const unsigned gen = old / nloc;
        if (old + 1u == (gen + 1u) * nloc) {
            __builtin_amdgcn_fence(__ATOMIC_RELEASE, "agent");
            asm volatile("s_waitcnt vmcnt(0)" ::: "memory");
            const unsigned og = xb_add(&bar[XB_TOP], 1u);
            const unsigned tg = og / nx;
            if (og + 1u == (tg + 1u) * nx) xb_add(&bar[XB_TOPGEN], 1u);
            else XB_SPIN(xb_ld(&bar[XB_TOPGEN]) == tg, bar);
            __builtin_amdgcn_fence(__ATOMIC_ACQUIRE, "agent");
            xb_add(&bar[XB_XGEN(b.x)], 1u);
            asm volatile("s_waitcnt vmcnt(0)" ::: "memory");
        } else {
            XB_SPIN(xb_ld(&bar[XB_XGEN(b.x)]) == gen, bar);
            __builtin_amdgcn_fence(__ATOMIC_ACQUIRE, "agent");
            asm volatile("s_waitcnt vmcnt(0)" ::: "memory");
        }
    }
    __syncthreads();
}

struct Args { const float* in[19]; float* out; unsigned char* ws; int ph_lo, ph_hi, li, pad; };

struct Frame {
    LAS unsigned char* lds;
    int tid, lane, wave, G, bid;
};
__device__ __forceinline__ unsigned long long pt_get(const Frame& F, int i) { const unsigned long long v = ((volatile LAS unsigned long long*)(F.lds + PT_OFF))[i];
    return ((unsigned long long)(unsigned)__builtin_amdgcn_readfirstlane((int)(v >> 32)) << 32) | (unsigned long long)(unsigned)__builtin_amdgcn_readfirstlane((int)(unsigned)v); }
#define IN_F(i) ((const float*)(GAS const float*)pt_get(F, (i)))
#define WSP ((unsigned char*)(GAS unsigned char*)pt_get(F, 19))
#define OUTP ((float*)(GAS float*)pt_get(F, 20))

struct TItem { const float* src; unsigned char* dst; const float* g; int N, K; float sc; };
__device__ __forceinline__ int gu_row(int n, int half) { return n < half ? ((n >> 7) * 256 + (n & 127)) : (((n - half) >> 7) * 256 + 128 + ((n - half) & 127)); }
__device__ __forceinline__ void ti_load(const TItem& t, f32x4 (&v)[16], int lane) {
    const float* p = t.src + (size_t)(16 * (lane >> 4)) * t.N + 4 * (lane & 15);
#pragma unroll
    for (int i = 0; i < 16; ++i) v[i] = __builtin_nontemporal_load((const f32x4*)(p + (size_t)i * t.N));
}
__device__ __forceinline__ void ti_store(const TItem& t, f32x4 (&v)[16], int lane) {
    const int kq = lane >> 4, nq = lane & 15;
    if (t.g) {
#pragma unroll
        for (int q = 0; q < 4; ++q) { const f32x4 gv = *(const f32x4*)(t.g + 16 * kq + 4 * q);
#pragma unroll
            for (int e = 0; e < 4; ++e) v[4 * q + e] = v[4 * q + e] * gv[e]; }
    }
    if (t.sc == 0.f) {
        unsigned char* d = t.dst + ((size_t)(4 * nq) * t.K + 16 * kq) * 2;
#pragma unroll
        for (int j = 0; j < 4; ++j)
#pragma unroll
            for (int c = 0; c < 2; ++c) { u32x4 o;
                o.x = pg8::cvt_pk_bf16(v[8 * c + 0][j], v[8 * c + 1][j]); o.y = pg8::cvt_pk_bf16(v[8 * c + 2][j], v[8 * c + 3][j]);
                o.z = pg8::cvt_pk_bf16(v[8 * c + 4][j], v[8 * c + 5][j]); o.w = pg8::cvt_pk_bf16(v[8 * c + 6][j], v[8 * c + 7][j]);
                *(u32x4*)(d + ((size_t)j * t.K + 8 * c) * 2) = o; }
    } else {
        unsigned char* d = t.dst + (size_t)(4 * nq) * t.K + 16 * kq; const float sc = t.sc;
#pragma unroll
        for (int j = 0; j < 4; ++j) { u32x4 o;
            o.x = pk4_fp8(v[0][j] * sc, v[1][j] * sc, v[2][j] * sc, v[3][j] * sc); o.y = pk4_fp8(v[4][j] * sc, v[5][j] * sc, v[6][j] * sc, v[7][j] * sc);
            o.z = pk4_fp8(v[8][j] * sc, v[9][j] * sc, v[10][j] * sc, v[11][j] * sc); o.w = pk4_fp8(v[12][j] * sc, v[13][j] * sc, v[14][j] * sc, v[15][j] * sc);
            *(u32x4*)(d + (size_t)j * t.K) = o; }
    }
}

constexpr int I_QKV = 16 * 20, I_O = 16 * 16, I_IN = 16 * 48, I_OUT = 16 * 16, I_GU1 = 32 * 256, I_DN1 = 32 * 128;
constexpr int Q0 = I_QKV, Q_O = Q0 + I_O, Q_GU0 = Q_O + I_GU1, Q_L0 = Q_O + I_GU1 + I_DN1, Q_IN = Q_L0 + I_IN, Q_OUT = Q_IN + I_OUT, Q_GU1 = Q_OUT + I_GU1, Q_L1 = Q_OUT + I_GU1 + I_DN1, NITEMS = Q_L1;
constexpr int CW_QHEAD = 16384 + 256, CW_DYN = 16384 + 512;
__device__ __forceinline__ void conv_resolve(const Frame& F, int it, TItem& t) {
    int r = it;
    if (r < Q0) { const int kb = r / 20, nb = r % 20; t.src = IN_F(5) + (size_t)(64 * kb) * QKVD + 64 * nb; t.dst = WSP + WS_WQKV + ((size_t)(64 * nb) * D + 64 * kb) * 2; t.g = IN_F(1) + 64 * kb; t.N = QKVD; t.K = D; t.sc = 0.f; return; } r -= Q0;
    if (r < I_O) { const int kb = r >> 4, nb = r & 15; t.src = IN_F(7) + (size_t)(64 * kb) * D + 64 * nb; t.dst = WSP + WS_WO + ((size_t)(64 * nb) * D + 64 * kb); t.g = nullptr; t.N = D; t.K = D; t.sc = 64.f; return; }   r -= I_O;
    int layer = 0;
    if (r >= I_GU1 + I_DN1) { r -= I_GU1 + I_DN1;
        if (r < I_IN) { const int kb = r / 48, nb = r % 48, n0 = 64 * nb; const int dr = n0 < 1024 ? n0 : 1024 + gu_row(n0 - 1024, 1024);
            t.src = IN_F(10) + (size_t)(64 * kb) * (3 * D) + n0; t.dst = WSP + WS_WIN + ((size_t)dr * D + 64 * kb) * 2; t.g = IN_F(1) + D + 64 * kb; t.N = 3 * D; t.K = D; t.sc = 0.f; return; } r -= I_IN;
        if (r < I_OUT) { const int kb = r >> 4, nb = r & 15; t.src = IN_F(12) + (size_t)(64 * kb) * D + 64 * nb; t.dst = WSP + WS_WOUT + ((size_t)(64 * nb) * D + 64 * kb); t.g = nullptr; t.N = D; t.K = D; t.sc = 64.f; return; }   r -= I_OUT;
        layer = 1; }
    if (r < I_GU1) { const int le = layer * 32 + (r >> 8), q = r & 255, kb = q >> 4, nb = q & 15, n0 = 64 * nb;
        t.src = IN_F(17) + (size_t)le * D * 1024 + (size_t)(64 * kb) * 1024 + n0; t.dst = WSP + WS_WGU + (size_t)le * 1024 * D + (size_t)gu_row(n0, 512) * D + 64 * kb; t.g = IN_F(2) + layer * D + 64 * kb; t.N = 1024; t.K = D; t.sc = 64.f; return; } r -= I_GU1;
    { const int le = layer * 32 + (r >> 7), q = r & 127, kb = q >> 4, nb = q & 15;
        t.src = IN_F(18) + (size_t)le * FF * D + (size_t)(64 * kb) * D + 64 * nb; t.dst = WSP + WS_WDN + (size_t)le * D * FF + (size_t)(64 * nb) * FF + 64 * kb; t.g = nullptr; t.N = D; t.K = FF; t.sc = 32.f; }
}
__device__ __forceinline__ void conv_run(const Frame& F, int first, int n) {
    const int end = (first + n) < NITEMS ? (first + n) : NITEMS;
    TItem ta, tb; f32x4 va[16], vb[16];
    int it = first + F.wave;
    if (it < end) { conv_resolve(F, it, ta); ti_load(ta, va, F.lane); }
    while (it < end) {
        const int it2 = it + NWAVES;
        if (it2 < end) { conv_resolve(F, it2, tb); ti_load(tb, vb, F.lane); }
        ti_store(ta, va, F.lane);
        if (it2 >= end) break;
        it = it2 + NWAVES;
        if (it < end) { conv_resolve(F, it, ta); ti_load(ta, va, F.lane); }
        ti_store(tb, vb, F.lane);
    }
}
__device__ __forceinline__ void conv_steal(const Frame& F, int quota, int limit, bool drain) {
    volatile LAS int* bc = (volatile LAS int*)(F.lds + MISC_OFF + 64);
    if (bc[2] >= limit) return;
    unsigned* qhead = (unsigned*)(WSP + WS_CTL) + CW_QHEAD;
    for (;;) {
        __syncthreads();
        if (F.tid == 0) { int base = -1, n = quota;
            int h = Q0 + (int)__hip_atomic_load(qhead, __ATOMIC_RELAXED, __HIP_MEMORY_SCOPE_AGENT);
            if (h < limit) { if (drain) { n = (((limit - h) + F.G - 1) / F.G + 7) & ~7; n = n < 8 ? 8 : (n > 128 ? 128 : n); }
                base = Q0 + (int)__hip_atomic_fetch_add(qhead, (unsigned)n, __ATOMIC_RELAXED, __HIP_MEMORY_SCOPE_AGENT); h = base + n; }
            bc[0] = base; bc[1] = n; if (h > bc[2]) bc[2] = h; }
        __syncthreads();
        const int base = bc[0], n = bc[1];
        if (base < 0 || base >= NITEMS) break;
        conv_run(F, base, n);
        if (!drain || base + n >= limit) break;
    }
    __syncthreads();
}

__device__ __forceinline__ void p0_prologue(Frame& F) {
    const int gw = F.bid * NWAVES + F.wave, NGW = F.G * NWAVES;
    const float* x = IN_F(0); const float* norm_ffn = IN_F(2);
    for (int it = F.bid + F.wave * F.G; it < Q0; it += NWAVES * F.G) { TItem t; f32x4 v[16]; conv_resolve(F, it, t); ti_load(t, v, F.lane); ti_store(t, v, F.lane); }
    {
        bf16_t* WR = (bf16_t*)(WSP + WS_WR); const float* wg = IN_F(13); const float* we = IN_F(15);
        const int RPW = (2 * 9 * 1024 + F.G - 1) / F.G, ZPW = (2 * 2 * 92 * 128 + F.G - 1) / F.G;
        for (int j0 = F.tid - 2 * 64; j0 >= 0 && j0 < RPW; j0 += NTHR - 2 * 64) { const int i = F.bid * RPW + j0; if (i >= 2 * 9 * 1024) break;
            const int l = i / (9 * 1024), q = (i / 1024) % 9, k = i & 1023;
            const f32x4 w4 = (q == 0) ? *(const f32x4*)(wg + (size_t)l * D * 4 + k * 4) : *(const f32x4*)(we + (size_t)l * D * 32 + k * 32 + (q - 1) * 4);
            const float g = norm_ffn[l * D + k]; const int n0 = (q == 0) ? 0 : 4 * q;
#pragma unroll
            for (int j = 0; j < 4; ++j) { const float w = w4[j] * g; const unsigned hi = f2bf(w); const float rem = w - __builtin_bit_cast(float, hi << 16);
                WR[((size_t)l * 256 + n0 + j) * 1024 + k] = (bf16_t)hi; WR[((size_t)l * 256 + 128 + n0 + j) * 1024 + k] = (bf16_t)f2bf(rem); }
        }
        for (int j0 = (F.tid + 4 * 64) % NTHR; j0 < ZPW; j0 += NTHR) { const int i = F.bid * ZPW + j0; if (i >= 2 * 2 * 92 * 128) break;
            const int l = i / (2 * 92 * 128), h = (i / (92 * 128)) & 1, r = (i / 128) % 92, c = i & 127;
            unsigned zz = 0u; asm volatile("" : "+v"(zz));
            *(u32x4*)(WR + ((size_t)l * 256 + h * 128 + 36 + r) * 1024 + c * 8) = (u32x4){zz, zz, zz, zz};
        }
    }
    {
        bf16_t* XB = (bf16_t*)(WSP + WS_XB); float* rs0 = (float*)(WSP + WS_RS0);
        for (int m = gw; m < T; m += NGW) {
            const GAS f32x4* xr = (const GAS f32x4*)(x + (size_t)m * D) + F.lane;
            f32x4 v[4]; float s = 0.f;
#pragma unroll
            for (int j = 0; j < 4; ++j) { v[j] = __builtin_nontemporal_load((const f32x4*)(x + (size_t)m * D) + F.lane + 64 * j); s += (v[j].x * v[j].x + v[j].y * v[j].y) + (v[j].z * v[j].z + v[j].w * v[j].w); }
            s = wave_sum(s);
            GAS u32x2* o8 = (GAS u32x2*)(XB + (size_t)m * D) + F.lane;
#pragma unroll
            for (int j = 0; j < 4; ++j) { u32x2 w; w.x = pk2(v[j].x, v[j].y); w.y = pk2(v[j].z, v[j].w); o8[64 * j] = w; }
            if (F.lane == 0) rs0[m] = 1.0f / sqrtf(s * (1.0f / D) + EPS);
        }
    }
}

struct DenseBase {
    static constexpr bool GATHER = false, AFTER_DRAIN = false, FP8 = false, WIDE = false, SIDE = false;
    static constexpr int EPI_OPS = 0;
    const char* Abase; const char* Bt; int K, nM, nN, nwg, G, c;
    __device__ __forceinline__ void init(const void* A, const void* B, int K_, int N, int G_, int c_) { Abase = (const char*)A; Bt = (const char*)B; K = K_; nM = T / 256; nN = N / 256; nwg = nM * nN; G = G_; c = c_; }
    __device__ __forceinline__ bool next(int i, pg8::Unit& u) const {
        const int L = i * G + c; if (L >= nwg) return false;
        const int wgid = pg8::xcd_remap(L, nwg);
        const int nig = pg8::WGM * nN, gid = wgid / nig, fm = gid * pg8::WGM, gsz = (nM - fm) < pg8::WGM ? (nM - fm) : pg8::WGM;
        u.pm = fm + ((wgid % nig) % gsz); u.pn = (wgid % nig) / gsz; u.nrows = 256; u.list = nullptr;
        u.bptr = Bt + (size_t)u.pn * 256 * K * 2; return true;
    }
    __device__ __forceinline__ void a_off(const pg8::Unit& u, LAS int*, int tid, unsigned (&voff)[2][2]) const {
#pragma unroll
        for (int i = 0; i < 2; ++i) { int R, C; pg8::stage_rc(tid * 16 + i * 8192, R, C);
#pragma unroll
            for (int h = 0; h < 2; ++h) voff[h][i] = (unsigned)((u.pm * 256 + h * 128 + R) * K + C) * 2u; }
    }
};
__device__ __forceinline__ u32x4 pack8(const f32x4& a, const f32x4& b) { u32x4 w; w.x = pg8::cvt_pk_bf16(a[0], a[1]); w.y = pg8::cvt_pk_bf16(a[2], a[3]); w.z = pg8::cvt_pk_bf16(b[0], b[1]); w.w = pg8::cvt_pk_bf16(b[2], b[3]); return w; }

__device__ __forceinline__ float sq8(const u32x4& w) { const float a = bf_lo(w.x), b = bf_hi(w.x), c = bf_lo(w.y), d = bf_hi(w.y), e = bf_lo(w.z), f = bf_hi(w.z), g = bf_lo(w.w), h = bf_hi(w.w);
    return ((a * a + b * b) + (c * c + d * d)) + ((e * e + f * f) + (g * g + h * h)); }
__device__ __forceinline__ unsigned dpp_xor1(unsigned v) { return (unsigned)__builtin_amdgcn_mov_dpp((int)v, 0xB1, 0xF, 0xF, true); }
__device__ __forceinline__ void pair_rows(u32x4& w0, u32x4& w1, int odd) {
    const u32x4 send = odd ? w0 : w1;
    u32x4 recv; recv.x = dpp_xor1(send.x); recv.y = dpp_xor1(send.y); recv.z = dpp_xor1(send.z); recv.w = dpp_xor1(send.w);
    if (odd) w0 = recv; else w1 = recv;
}
struct PolQKV : DenseBase {
    static constexpr bool WIDE = true, SIDE = true; static constexpr int EPI_OPS = 16;
    bf16_t* O; const float* side; const float* bias;
    __device__ __forceinline__ void epi(const pg8::Acc& acc, const pg8::Unit& u, LAS int* lst, int wr, int wc, int fr, int fq) const {
        const float sc = (u.pn < 4) ? QSCALE : 1.0f;
        const int col0 = u.pn * 256 + wc * 64 + 16 * fq, row0 = u.pm * 256 + wr * 64 + fr;
        f32x4 bv[2][2]; float rv[2][4];
#pragma unroll
        for (int ai = 0; ai < 2; ++ai)
#pragma unroll
            for (int m = 0; m < 4; ++m) rv[ai][m] = ((const LAS float*)lst)[wr * 64 + fr + ai * 128 + m * 16];
#pragma unroll
        for (int bj = 0; bj < 2; ++bj)
#pragma unroll
            for (int n = 0; n < 2; ++n) bv[bj][n] = *(const f32x4*)(bias + col0 + 8 * bj + 4 * n);
#pragma unroll
        for (int ai = 0; ai < 2; ++ai)
#pragma unroll
            for (int m = 0; m < 4; ++m) { const int row = row0 + ai * 128 + m * 16; const float r = rv[ai][m];
                u32x4 w[2];
#pragma unroll
                for (int bj = 0; bj < 2; ++bj) { const f32x4 v0 = (acc[ai][bj][m][0] * r + bv[bj][0]) * sc, v1 = (acc[ai][bj][m][1] * r + bv[bj][1]) * sc; w[bj] = pack8(v0, v1); }
                const int odd = fr & 1; pair_rows(w[0], w[1], odd);
                *(u32x4*)(O + (size_t)(row - odd) * QKVD + col0 + 8 * odd) = w[0]; *(u32x4*)(O + (size_t)(row - odd + 1) * QKVD + col0 + 8 * odd) = w[1]; }
    }
};
struct PolOproj : DenseBase {
    static constexpr bool WIDE = true, FP8 = true; int scale_w, scale_a;
    bf16_t* O; const bf16_t* xb; const float* bias; float* ssq; unsigned char* H8;
    __device__ __forceinline__ void epi(const pg8::Acc& acc, const pg8::Unit& u, LAS int*, int wr, int wc, int fr, int fq) const {
        const int col0 = u.pn * 256 + wc * 64 + 16 * fq, row0 = u.pm * 256 + wr * 64 + fr;
        f32x4 bv[2][2];
#pragma unroll
        for (int bj = 0; bj < 2; ++bj)
#pragma unroll
            for (int n = 0; n < 2; ++n) bv[bj][n] = *(const f32x4*)(bias + col0 + 8 * bj + 4 * n);
#pragma unroll
        for (int ai = 0; ai < 2; ++ai) {
            u32x4 hv[4][2];
#pragma unroll
            for (int m = 0; m < 4; ++m)
#pragma unroll
                for (int bj = 0; bj < 2; ++bj) hv[m][bj] = *(const u32x4*)(xb + (size_t)(row0 + ai * 128 + m * 16) * D + col0 + 8 * bj);
#pragma unroll
            for (int m = 0; m < 4; ++m) { const int row = row0 + ai * 128 + m * 16;
                u32x4 w[2];
#pragma unroll
                for (int bj = 0; bj < 2; ++bj) { const u32x4 hw = hv[m][bj];
                    const f32x4 h0 = {bf_lo(hw.x), bf_hi(hw.x), bf_lo(hw.y), bf_hi(hw.y)}, h1 = {bf_lo(hw.z), bf_hi(hw.z), bf_lo(hw.w), bf_hi(hw.w)};
                    w[bj] = pack8(acc[ai][bj][m][0] + bv[bj][0] + h0, acc[ai][bj][m][1] + bv[bj][1] + h1); }
                float sq = sq8(w[0]) + sq8(w[1]);
                u32x4 q8; q8.x = pk4_fp8(bf_lo(w[0].x), bf_hi(w[0].x), bf_lo(w[0].y), bf_hi(w[0].y)); q8.y = pk4_fp8(bf_lo(w[0].z), bf_hi(w[0].z), bf_lo(w[0].w), bf_hi(w[0].w));
                q8.z = pk4_fp8(bf_lo(w[1].x), bf_hi(w[1].x), bf_lo(w[1].y), bf_hi(w[1].y)); q8.w = pk4_fp8(bf_lo(w[1].z), bf_hi(w[1].z), bf_lo(w[1].w), bf_hi(w[1].w));
                *(u32x4*)(H8 + (size_t)row * D + col0) = q8;
                sq += __shfl_xor(sq, 16); sq += __shfl_xor(sq, 32);
                if (fq == 0) ssq[(size_t)row * 16 + u.pn * 4 + wc] = sq;
                { const int odd = fr & 1; pair_rows(w[0], w[1], odd);
                  *(u32x4*)(O + (size_t)(row - odd) * D + col0 + 8 * odd) = w[0]; *(u32x4*)(O + (size_t)(row - odd + 1) * D + col0 + 8 * odd) = w[1]; } }
            asm volatile("" ::: "memory"); }
    }
};
struct PolConvIn : DenseBase {
    static constexpr bool SIDE = true; static constexpr int EPI_OPS = 8;
    bf16_t* BG; bf16_t* Z; const float* side;
    __device__ __forceinline__ void epi(const pg8::Acc& acc, const pg8::Unit& u, LAS int* lst, int wr, int wc, int fr, int fq) const {
        const int row0 = u.pm * 256 + wr * 64 + fr;
        float rv[2][4];
#pragma unroll
        for (int ai = 0; ai < 2; ++ai)
#pragma unroll
            for (int m = 0; m < 4; ++m) rv[ai][m] = ((const LAS float*)lst)[wr * 64 + fr + ai * 128 + m * 16];
        if (u.pn < 4) {
#pragma unroll
            for (int ai = 0; ai < 2; ++ai)
#pragma unroll
                for (int m = 0; m < 4; ++m) { const int row = row0 + ai * 128 + m * 16; const float r = rv[ai][m];
#pragma unroll
                    for (int bj = 0; bj < 2; ++bj) *(u32x4*)(BG + (size_t)row * D + u.pn * 256 + bj * 128 + wc * 32 + 8 * fq) = pack8(acc[ai][bj][m][0] * r, acc[ai][bj][m][1] * r); }
        } else {
#pragma unroll
            for (int ai = 0; ai < 2; ++ai)
#pragma unroll
                for (int m = 0; m < 4; ++m) { const int row = row0 + ai * 128 + m * 16; const float r2 = rv[ai][m] * rv[ai][m];
                    *(u32x4*)(Z + (size_t)row * D + (u.pn - 4) * 128 + wc * 32 + 8 * fq) = pack8(acc[ai][0][m][0] * acc[ai][1][m][0] * r2, acc[ai][0][m][1] * acc[ai][1][m][1] * r2); }
        }
    }
};
struct PolConvOut : DenseBase {
    static constexpr bool WIDE = true, FP8 = true; int scale_w, scale_a;
    bf16_t* O; const bf16_t* H; float* ssq; unsigned char* H8;
    __device__ __forceinline__ void epi(const pg8::Acc& acc, const pg8::Unit& u, LAS int*, int wr, int wc, int fr, int fq) const {
        const int col0 = u.pn * 256 + wc * 64 + 16 * fq, row0 = u.pm * 256 + wr * 64 + fr;
        u32x4 hva[2][4][2];
#pragma unroll
        for (int ai = 0; ai < 2; ++ai)
#pragma unroll
            for (int m = 0; m < 4; ++m)
#pragma unroll
                for (int bj = 0; bj < 2; ++bj) hva[ai][m][bj] = *(const u32x4*)(H + (size_t)(row0 + ai * 128 + m * 16) * D + col0 + 8 * bj);
        asm volatile("" ::: "memory");
#pragma unroll
        for (int ai = 0; ai < 2; ++ai) {
#pragma unroll
            for (int m = 0; m < 4; ++m) { const int row = row0 + ai * 128 + m * 16;
                u32x4 w[2];
#pragma unroll
                for (int bj = 0; bj < 2; ++bj) { const u32x4 hw = hva[ai][m][bj];
                    const f32x4 h0 = {bf_lo(hw.x), bf_hi(hw.x), bf_lo(hw.y), bf_hi(hw.y)}, h1 = {bf_lo(hw.z), bf_hi(hw.z), bf_lo(hw.w), bf_hi(hw.w)};
                    w[bj] = pack8(acc[ai][bj][m][0] + h0, acc[ai][bj][m][1] + h1); }
                float sq = sq8(w[0]) + sq8(w[1]);
                u32x4 q8; q8.x = pk4_fp8(bf_lo(w[0].x), bf_hi(w[0].x), bf_lo(w[0].y), bf_hi(w[0].y)); q8.y = pk4_fp8(bf_lo(w[0].z), bf_hi(w[0].z), bf_lo(w[0].w), bf_hi(w[0].w));
                q8.z = pk4_fp8(bf_lo(w[1].x), bf_hi(w[1].x), bf_lo(w[1].y), bf_hi(w[1].y)); q8.w = pk4_fp8(bf_lo(w[1].z), bf_hi(w[1].z), bf_lo(w[1].w), bf_hi(w[1].w));
                *(u32x4*)(H8 + (size_t)row * D + col0) = q8;
                sq += __shfl_xor(sq, 16); sq += __shfl_xor(sq, 32);
                if (fq == 0) ssq[(size_t)row * 16 + u.pn * 4 + wc] = sq;
                { const int odd = fr & 1; pair_rows(w[0], w[1], odd);
                  *(u32x4*)(O + (size_t)(row - odd) * D + col0 + 8 * odd) = w[0]; *(u32x4*)(O + (size_t)(row - odd + 1) * D + col0 + 8 * odd) = w[1]; } }
            asm volatile("" ::: "memory"); }
    }
};
constexpr int RT_LG = 0, RT_RE = 40960, RT_RG = RT_RE + 2048, RT_RK = RT_RG + 2048, RT_RS = RT_RK + 2048, RT_CNT = RT_RS + 1024, RT_BASE = RT_CNT + 128;
struct PolRoute : DenseBase {
    static constexpr bool AFTER_DRAIN = true;
    LAS unsigned char* lds; const float* ssq; const float* bg; const float* be; unsigned* ecount; int* elist; float* gate; float* ascale; int tid;
    __device__ __forceinline__ void epi(const pg8::Acc& acc, const pg8::Unit& u, LAS int*, int wr, int wc, int fr, int fq) const {
        LAS float* LG = (LAS float*)(lds + RT_LG); LAS int* RE = (LAS int*)(lds + RT_RE); LAS float* RG = (LAS float*)(lds + RT_RG); LAS int* RK = (LAS int*)(lds + RT_RK);
        LAS float* RS = (LAS float*)(lds + RT_RS); LAS int* CNT = (LAS int*)(lds + RT_CNT); LAS int* BASE = (LAS int*)(lds + RT_BASE);
        if (tid < 32) CNT[tid] = 0;
        if (wc < 2) {
#pragma unroll
            for (int ai = 0; ai < 2; ++ai)
#pragma unroll
                for (int m = 0; m < 4; ++m) { const int rl = ai * 128 + wr * 64 + m * 16 + fr;
                    if (wc == 0) {
#pragma unroll
                        for (int n = 0; n < 2; ++n) *(LAS f32x4*)(LG + rl * 40 + 8 * fq + 4 * n) = acc[ai][0][m][n] + acc[ai][1][m][n];
                    } else if (fq == 0) *(LAS f32x4*)(LG + rl * 40 + 32) = acc[ai][0][m][0] + acc[ai][1][m][0]; }
        }
        __syncthreads();
        const int tok0 = u.pm * 256;
        if (tid < 256) {
            const int t = tid; const float* sp = ssq + (size_t)(tok0 + t) * 16; float sq = 0.f;
#pragma unroll
            for (int i = 0; i < 4; ++i) { const f32x4 v = *(const f32x4*)(sp + 4 * i); sq += (v[0] + v[1]) + (v[2] + v[3]); }
            const float rs = 1.0f / sqrtf(sq * (1.0f / D) + EPS);
            const LAS float* L = LG + t * 40;
            float lg[4];
#pragma unroll
            for (int j = 0; j < 4; ++j) lg[j] = L[j] * rs + bg[j];
            int gi = 0; float gm = lg[0];
#pragma unroll
            for (int j = 1; j < 4; ++j) if (lg[j] > gm) { gm = lg[j]; gi = j; }
            float gs = 0.f;
#pragma unroll
            for (int j = 0; j < 4; ++j) gs += __expf(lg[j] - gm);
            const float gp = 1.0f / gs;
            float le[8];
#pragma unroll
            for (int j = 0; j < 8; ++j) le[j] = L[4 + 8 * gi + j] * rs + be[8 * gi + j];
            int j1 = 0; float m1 = le[0];
#pragma unroll
            for (int j = 1; j < 8; ++j) if (le[j] > m1) { m1 = le[j]; j1 = j; }
            int j2 = -1; float m2 = -3.0e38f;
#pragma unroll
            for (int j = 0; j < 8; ++j) if (j != j1 && le[j] > m2) { m2 = le[j]; j2 = j; }
            const float p1 = 1.0f / (1.0f + __expf(m2 - m1));
            const int e1 = 8 * gi + j1, e2 = 8 * gi + j2;
            RS[t] = rs; RE[2 * t] = e1; RE[2 * t + 1] = e2; RG[2 * t] = gp * p1; RG[2 * t + 1] = gp * (1.0f - p1);
            RK[2 * t] = __hip_atomic_fetch_add(CNT + e1, 1, __ATOMIC_RELAXED, __HIP_MEMORY_SCOPE_WORKGROUP); RK[2 * t + 1] = __hip_atomic_fetch_add(CNT + e2, 1, __ATOMIC_RELAXED, __HIP_MEMORY_SCOPE_WORKGROUP);
        }
        __syncthreads();
        if (tid < 32) BASE[tid] = (int)__hip_atomic_fetch_add(ecount + tid, (unsigned)CNT[tid], __ATOMIC_RELAXED, __HIP_MEMORY_SCOPE_AGENT);
        __syncthreads();
        { const int i = tid, a = 2 * tok0 + i, e = RE[i];
          const float rsv = RS[i >> 1], gtv = RG[i]; u32x4 en; en.x = (unsigned)a; en.y = __float_as_uint(rsv); en.z = __float_as_uint(gtv); en.w = 0u;
          *(u32x4*)(elist + ((size_t)e * T + BASE[e] + RK[i]) * 4) = en; }
        __syncthreads();
    }
};
struct MoeBase {
    static constexpr bool GATHER = true, AFTER_DRAIN = false, FP8 = true, WIDE = false, SIDE = false;
    static constexpr int EPI_OPS = 0;
    int scale_w, scale_a;
    const char* Abase; const char* W; int K, G, c; size_t wstride;
    const int* elist; LAS int* etab;
    __device__ __forceinline__ bool next(int i, pg8::Unit& u) const {
        const int ntile = __builtin_amdgcn_readfirstlane(etab[32 + 32]), nwg = ntile * 4;
        const int L = i * G + c; if (L >= nwg) return false;
        const int wgid = pg8::xcd_remap(L, nwg);
        const int tile = wgid >> 2; u.pn = wgid & 3;
        const int em = __builtin_amdgcn_readfirstlane(etab[72 + tile]), e = em & 31, mt = em >> 5;
        const int cnt = __builtin_amdgcn_readfirstlane(etab[e]);
        u.pm = e; u.nrows = (cnt - mt * 256) < 256 ? (cnt - mt * 256) : 256;
        u.list = elist + ((size_t)e * T + mt * 256) * 4;
        u.bptr = W + (size_t)e * wstride + (size_t)u.pn * 256 * K * 2;
        return true;
    }
};
struct PolMoe1 : MoeBase {
    unsigned char* ACT; const float* ascale;
    __device__ __forceinline__ void a_off(const pg8::Unit& u, LAS int* lst, int tid, unsigned (&voff)[2][2]) const {
#pragma unroll
        for (int i = 0; i < 2; ++i) { int R, C; pg8::stage_rc(tid * 16 + i * 8192, R, C);
#pragma unroll
            for (int h = 0; h < 2; ++h) { const int rl = h * 128 + R; const int a = lst[(rl < u.nrows ? rl : 0) * 4]; voff[h][i] = (unsigned)((a >> 1) * K + C) * 2u; } }
    }
    __device__ __forceinline__ void epi(const pg8::Acc& acc, const pg8::Unit& u, LAS int* lst, int wr, int wc, int fr, int fq) const {
        int av[2][4]; float rv[2][4];
#pragma unroll
        for (int ai = 0; ai < 2; ++ai)
#pragma unroll
            for (int m = 0; m < 4; ++m) { const int rl = ai * 128 + wr * 64 + m * 16 + fr; const u32x2 en = *(const LAS u32x2*)(lst + (rl < u.nrows ? rl : 0) * 4); av[ai][m] = (int)en.x; rv[ai][m] = __uint_as_float(en.y); }
#pragma unroll
        for (int ai = 0; ai < 2; ++ai)
#pragma unroll
            for (int m = 0; m < 4; ++m) { const int rl = ai * 128 + wr * 64 + m * 16 + fr;
                if (rl < u.nrows) { const int a = av[ai][m]; const float r = rv[ai][m]; f32x4 v[2];
#pragma unroll
                    for (int n = 0; n < 2; ++n)
#pragma unroll
                        for (int j = 0; j < 4; ++j) { const float g = acc[ai][0][m][n][j] * r, uu = acc[ai][1][m][n][j] * r; v[n][j] = g * __builtin_amdgcn_rcpf(1.0f + __builtin_amdgcn_exp2f(-g * LOG2E)) * uu; }
                    u32x2 q8; q8.x = pk4_fp8(v[0][0] * 4.f, v[0][1] * 4.f, v[0][2] * 4.f, v[0][3] * 4.f); q8.y = pk4_fp8(v[1][0] * 4.f, v[1][1] * 4.f, v[1][2] * 4.f, v[1][3] * 4.f);
                    *(u32x2*)(ACT + (size_t)a * FF + u.pn * 128 + wc * 32 + 8 * fq) = q8; } }
    }
};
struct PolMoe2 : MoeBase {
    static constexpr bool WIDE = true;
    unsigned char* Y; const float* gate;
    __device__ __forceinline__ void a_off(const pg8::Unit& u, LAS int* lst, int tid, unsigned (&voff)[2][2]) const {
#pragma unroll
        for (int i = 0; i < 2; ++i) { int R, C; pg8::stage_rc(tid * 16 + i * 8192, R, C);
#pragma unroll
            for (int h = 0; h < 2; ++h) { const int rl = h * 128 + R; const int a = lst[(rl < u.nrows ? rl : 0) * 4]; voff[h][i] = (unsigned)(a * K + C) * 2u; } }
    }
    __device__ __forceinline__ void epi(const pg8::Acc& acc, const pg8::Unit& u, LAS int* lst, int wr, int wc, int fr, int fq) const {
        int av[2][4]; float gv[2][4];
#pragma unroll
        for (int ai = 0; ai < 2; ++ai)
#pragma unroll
            for (int m = 0; m < 4; ++m) { const int rl = ai * 128 + wr * 64 + m * 16 + fr; const u32x4 en = *(const LAS u32x4*)(lst + (rl < u.nrows ? rl : 0) * 4); av[ai][m] = (int)en.x; gv[ai][m] = __uint_as_float(en.z) * 16.0f; }
#pragma unroll
        for (int ai = 0; ai < 2; ++ai)
#pragma unroll
            for (int m = 0; m < 4; ++m) { const int rl = ai * 128 + wr * 64 + m * 16 + fr;
                if (rl < u.nrows) { const int a = av[ai][m]; const float g = gv[ai][m]; u32x4 q8;
#pragma unroll
                    for (int bj = 0; bj < 2; ++bj) { const f32x4 v0 = acc[ai][bj][m][0] * g, v1 = acc[ai][bj][m][1] * g; q8[2 * bj] = pk4_fp8(v0[0], v0[1], v0[2], v0[3]); q8[2 * bj + 1] = pk4_fp8(v1[0], v1[1], v1[2], v1[3]); }
                    *(u32x4*)(Y + (size_t)a * D + u.pn * 256 + wc * 64 + 16 * fq) = q8; } }
    }
};
__device__ __forceinline__ void moe_build_etab(Frame& F, const unsigned* ecount) {
    LAS int* etab = (LAS int*)(F.lds + ETAB_OFF);
    if (F.tid < 32) etab[F.tid] = (int)__hip_atomic_load(ecount + F.tid, __ATOMIC_RELAXED, __HIP_MEMORY_SCOPE_AGENT);
    __syncthreads();
    if (F.tid == 0) { int s = 0; for (int e = 0; e < 32; ++e) { etab[32 + e] = s; s += (etab[e] + 255) >> 8; } etab[64] = s; }
    __syncthreads();
    if (F.tid < etab[64] && F.tid < 288) { int e = 0; for (int j = 1; j < 32; ++j) e += (etab[32 + j] <= F.tid) ? 1 : 0; etab[72 + F.tid] = e | ((F.tid - etab[32 + e]) << 5); }
    __syncthreads();
}

constexpr int AT_K = 0, AT_V = 32768, AT_TAB = 65536, AT_WSF = AT_TAB + 16 * 384 * 4, AT_OST = AT_WSF + 8 * 64 * 4;
constexpr float ATT_SHIFT = 16.0f;
__device__ __forceinline__ int t5_bucket(int d) { if (d < 16) return d; int b = 16 + (int)(logf((float)d / 16.0f) / 2.0794415416798357f * 16.0f); return b < 31 ? b : 31; }
__device__ __forceinline__ void attn_build_tab(Frame& F) {
    LAS float* tab = (LAS float*)(F.lds + RING_OFF + AT_TAB); const float* rel = IN_F(4);
    const int d = F.tid & 127, bk = t5_bucket(d), h0 = F.tid >> 7;
    float bv[4];
#pragma unroll
    for (int i = 0; i < 4; ++i) bv[i] = rel[bk * 16 + h0 + 4 * i];
    for (int i = F.tid; i < 16 * 384; i += NTHR) { const int j = i % 384; if (j < 128 || j > 255) tab[i] = -1e30f; }
#pragma unroll
    for (int i = 0; i < 4; ++i) tab[(h0 + 4 * i) * 384 + 255 - d] = bv[i] * LOG2E - ATT_SHIFT;
    __syncthreads();
}
__device__ __forceinline__ s16x4 vtr(const LAS unsigned char* p) { typedef short v4i16_t __attribute__((ext_vector_type(4))); return __builtin_bit_cast(s16x4, __builtin_amdgcn_ds_read_tr16_b64_v4i16((LAS v4i16_t*)p)); }
__device__ __forceinline__ int crow(int r, int hi) { return (r & 3) + 8 * (r >> 2) + 4 * hi; }

#if ATTN_NAIVE
__device__ __forceinline__ void attn_phase(Frame& F) {
    attn_build_tab(F);
    const LAS float* tab = (const LAS float*)(F.lds + RING_OFF + AT_TAB);
    const bf16_t* QKV = (const bf16_t*)(WSP + WS_QKV); bf16_t* O = (bf16_t*)(WSP + WS_O); const float* sinks = IN_F(9);
    for (int idx = F.bid * NTHR + F.tid; idx < T * NH; idx += F.G * NTHR) {
        const int t = idx >> 4, h = idx & 15, hk = h >> 3, pos = t & (SEQ - 1);
        float q[64], o[64];
        const bf16_t* qp = QKV + (size_t)t * QKVD + h * 64;
#pragma unroll
        for (int d = 0; d < 64; ++d) { q[d] = bf2f(qp[d]); o[d] = 0.f; }
        float m = sinks[h] * LOG2E, l = 1.0f;
        const int k0 = pos - 127 < 0 ? 0 : pos - 127;
        for (int kp = k0; kp <= pos; ++kp) {
            const bf16_t* kr = QKV + (size_t)(t - pos + kp) * QKVD + 1024 + hk * 64; const bf16_t* vr = kr + 128;
            float s = 0.f;
#pragma unroll
            for (int d = 0; d < 64; ++d) s += q[d] * bf2f(kr[d]);
            s += tab[h * 384 + 255 - (pos - kp)];
            const float mn = fmaxf(m, s), al = __builtin_amdgcn_exp2f(m - mn), pp = __builtin_amdgcn_exp2f(s - mn);
            l = l * al + pp; m = mn;
#pragma unroll
            for (int d = 0; d < 64; ++d) o[d] = o[d] * al + pp * bf2f(vr[d]);
        }
        const float rl = 1.0f / l; bf16_t* op = O + (size_t)t * D + h * 64;
#pragma unroll
        for (int d = 0; d < 64; d += 2) *(unsigned*)(op + d) = pk2(o[d] * rl, o[d + 1] * rl);
    }
    __syncthreads();
}
#else
__device__ __forceinline__ void attn_phase(Frame& F) {
    attn_build_tab(F);
    const int lane = F.lane, wid = F.wave, r32 = lane & 31, hi = lane >> 5;
    const bf16_t* QKV = (const bf16_t*)(WSP + WS_QKV); unsigned char* O = WSP + WS_O; const float* sinks = IN_F(9);
    LAS unsigned char* const lds = F.lds + RING_OFF;
    LAS float* wsf = (LAS float*)(lds + AT_WSF) + wid * 64;
    const LAS unsigned char* vp0 = lds + AT_V + ((lane >> 4) & 1) * 32 + (lane & 3) * 8 + (4 * hi + ((lane & 15) >> 2)) * 64;
    LAS unsigned char* stg = lds + AT_OST + wid * 4096;
    bf16x8 qn[4];
    { const int unit = F.bid; if (unit < 512) { const int b = unit >> 6, n = (unit & 63) >> 1, h = (unit & 1) * 8 + wid; const size_t qrow = (size_t)b * SEQ + (size_t)(128 * n + r32);
#pragma unroll
        for (int d0 = 0; d0 < 4; ++d0) qn[d0] = *(const bf16x8*)(QKV + qrow * QKVD + h * 64 + d0 * 16 + hi * 8); } }
    u32x4 kvr[8];
    auto kv_load = [&](int unit) {
        const int b = unit >> 6, n = (unit & 63) >> 1, hk = unit & 1; const size_t rowb = (size_t)b * SEQ;
#pragma unroll
        for (int i = 0; i < 4; ++i) {
            const int p = wid * 4 + i, slot = p >> 3;
            if (n > 0 || slot >= 2) {
                { const int chunk = p & 7, key = slot * 64 + lane; const size_t row = rowb + (size_t)(128 * (n - 1) + key); kvr[2 * i] = *(const u32x4*)(QKV + row * QKVD + 1024 + hk * 64 + chunk * 8); }
                { const int dh = (p >> 2) & 1, rg = p & 3, key = slot * 64 + rg * 16 + (lane >> 2); const size_t row = rowb + (size_t)(128 * (n - 1) + key); kvr[2 * i + 1] = *(const u32x4*)(QKV + row * QKVD + 1152 + hk * 64 + dh * 32 + (lane & 3) * 8); }
            }
        }
    };
    if (F.bid < 512) kv_load(F.bid);
    for (int unit = F.bid; unit < 512; unit += F.G) {
        const int b = unit >> 6, n = (unit & 63) >> 1, hk = unit & 1;
        const size_t rowb = (size_t)b * SEQ;
#pragma unroll
        for (int i = 0; i < 4; ++i) {
            const int p = wid * 4 + i, slot = p >> 3;
            if (n > 0 || slot >= 2) { *(LAS u32x4*)(lds + AT_K + p * 1024 + lane * 16) = kvr[2 * i]; *(LAS u32x4*)(lds + AT_V + p * 1024 + lane * 16) = kvr[2 * i + 1]; }
        }
        __syncthreads();
        if (unit + F.G < 512) kv_load(unit + F.G);
        const int h = hk * 8 + wid;
        const LAS float* tabh = (const LAS float*)(lds + AT_TAB) + h * 384;
        const float sinkp = __builtin_amdgcn_exp2f(sinks[h] * LOG2E - ATT_SHIFT);
        for (int a = 0; a < 4; ++a) {
            bf16x8 qr[4];
#pragma unroll
            for (int d0 = 0; d0 < 4; ++d0) qr[d0] = qn[d0];
            { int nu = unit, na = a + 1; if (na == 4) { na = 0; nu = unit + F.G; }
              if (nu < 512) { const int nb = nu >> 6, nn = (nu & 63) >> 1, nh = (nu & 1) * 8 + wid; const size_t qrow = (size_t)nb * SEQ + (size_t)(128 * nn + 32 * na + r32);
#pragma unroll
                for (int d0 = 0; d0 < 4; ++d0) qn[d0] = *(const bf16x8*)(QKV + qrow * QKVD + nh * 64 + d0 * 16 + hi * 8); } }
            float lrun = (hi == 0) ? sinkp : 0.0f;
            f32x16 o0 = {}, o1 = {};
            int jt_lo = (a < 2) ? 0 : 1; const int jt_hi = (a < 2) ? 2 : 3;
            if (n == 0 && jt_lo < 2) jt_lo = 2;
            for (int jt = jt_lo; jt <= jt_hi; ++jt) {
                const LAS unsigned char* kb = lds + AT_K + jt * 8192 + hi * 1024 + r32 * 16;
                const LAS float* tp = tabh + (127 - (32 * a + r32) + 4 * hi) + 64 * jt;
                f32x16 p0, p1;
#pragma unroll
                for (int r = 0; r < 16; ++r) { const int ko = (r & 3) + 8 * (r >> 2); p0[r] = tp[ko]; p1[r] = tp[32 + ko]; }
#pragma unroll
                for (int d0 = 0; d0 < 4; ++d0) {
                    const bf16x8 b0 = *(const LAS bf16x8*)(kb + d0 * 2048), b1 = *(const LAS bf16x8*)(kb + d0 * 2048 + 512);
                    p0 = __builtin_amdgcn_mfma_f32_32x32x16_bf16(b0, qr[d0], p0, 0, 0, 0);
                    p1 = __builtin_amdgcn_mfma_f32_32x32x16_bf16(b1, qr[d0], p1, 0, 0, 0);
                }
#pragma unroll
                for (int r = 0; r < 16; ++r) { p0[r] = __builtin_amdgcn_exp2f(p0[r]); p1[r] = __builtin_amdgcn_exp2f(p1[r]); }
                float st[8];
#pragma unroll
                for (int r = 0; r < 8; ++r) st[r] = (p0[r] + p1[r]) + (p0[r + 8] + p1[r + 8]);
                lrun += ((st[0] + st[1]) + (st[2] + st[3])) + ((st[4] + st[5]) + (st[6] + st[7]));
                u32x4 pw[4];
                pw[0] = (u32x4){pg8::cvt_pk_bf16(p0[0], p0[1]), pg8::cvt_pk_bf16(p0[2], p0[3]), pg8::cvt_pk_bf16(p0[4], p0[5]), pg8::cvt_pk_bf16(p0[6], p0[7])};
                pw[1] = (u32x4){pg8::cvt_pk_bf16(p0[8], p0[9]), pg8::cvt_pk_bf16(p0[10], p0[11]), pg8::cvt_pk_bf16(p0[12], p0[13]), pg8::cvt_pk_bf16(p0[14], p0[15])};
                pw[2] = (u32x4){pg8::cvt_pk_bf16(p1[0], p1[1]), pg8::cvt_pk_bf16(p1[2], p1[3]), pg8::cvt_pk_bf16(p1[4], p1[5]), pg8::cvt_pk_bf16(p1[6], p1[7])};
                pw[3] = (u32x4){pg8::cvt_pk_bf16(p1[8], p1[9]), pg8::cvt_pk_bf16(p1[10], p1[11]), pg8::cvt_pk_bf16(p1[12], p1[13]), pg8::cvt_pk_bf16(p1[14], p1[15])};
                const LAS unsigned char* vp = vp0 + jt * 8192;
#pragma unroll
                for (int ks = 0; ks < 4; ++ks) {
                    const bf16x8 pa = __builtin_bit_cast(bf16x8, pw[ks]);
                    { const s16x4 lo = vtr(vp + ks * 1024), hh = vtr(vp + ks * 1024 + 512);
                      const bf16x8 vf = {lo[0], lo[1], lo[2], lo[3], hh[0], hh[1], hh[2], hh[3]};
                      o0 = __builtin_amdgcn_mfma_f32_32x32x16_bf16(pa, vf, o0, 0, 0, 0); }
                    { const s16x4 lo = vtr(vp + 4096 + ks * 1024), hh = vtr(vp + 4096 + ks * 1024 + 512);
                      const bf16x8 vf = {lo[0], lo[1], lo[2], lo[3], hh[0], hh[1], hh[2], hh[3]};
                      o1 = __builtin_amdgcn_mfma_f32_32x32x16_bf16(pa, vf, o1, 0, 0, 0); }
                }
            }
            lrun += __shfl_xor(lrun, 32);
            if (hi == 0) wsf[32 + r32] = 1.0f / lrun;
            LDS_WAIT();
#pragma unroll
            for (int r = 0; r < 16; ++r) { const int qq = crow(r, hi); const float f = wsf[32 + qq] * 4.0f;
                const unsigned w = (unsigned)__builtin_amdgcn_cvt_pk_fp8_f32(o0[r] * f, o1[r] * f, 0, false); stg[qq * 64 + r32] = (unsigned char)(w & 0xffu); stg[qq * 64 + 32 + r32] = (unsigned char)((w >> 8) & 0xffu); }
            LDS_WAIT();
            unsigned char* ob = O + (rowb + (size_t)(128 * n + 32 * a)) * D + h * 64;
#pragma unroll
            for (int i = 0; i < 2; ++i) { const int row = i * 16 + (lane >> 2), ch = lane & 3; const u32x4 v = *(const LAS u32x4*)(stg + row * 64 + ch * 16); *(u32x4*)(ob + (size_t)row * D + ch * 16) = v; }
            LDS_WAIT();
        }
        __syncthreads();
    }
}
#endif

template <bool FINAL>
__device__ __forceinline__ void combine_phase(Frame& F, const bf16_t* H, const unsigned char* Y, bf16_t* HO, float* rs_out, unsigned* ticket) {
    typedef float f32x2v __attribute__((ext_vector_type(2)));
    const int gw = F.bid * NWAVES + F.wave, NGW = F.G * NWAVES, lane = F.lane;
    const float* fn = IN_F(3); float* const outp = OUTP;
    auto row = [&](const int t) {
        const u32x4* hp = (const u32x4*)(H + (size_t)t * D) + lane; const u32x2* y0 = (const u32x2*)(Y + (size_t)(2 * t) * D) + lane; const u32x2* y1 = (const u32x2*)(Y + (size_t)(2 * t + 1) * D) + lane;
        float v[16];
#pragma unroll
        for (int j = 0; j < 2; ++j) { const u32x4 a = __builtin_nontemporal_load(hp + 64 * j); const u32x2 b = __builtin_nontemporal_load(y0 + 64 * j), c = __builtin_nontemporal_load(y1 + 64 * j);
            const f32x2v b0 = __builtin_amdgcn_cvt_pk_f32_fp8((int)b.x, false), b1 = __builtin_amdgcn_cvt_pk_f32_fp8((int)b.x, true), b2 = __builtin_amdgcn_cvt_pk_f32_fp8((int)b.y, false), b3 = __builtin_amdgcn_cvt_pk_f32_fp8((int)b.y, true);
            const f32x2v c0 = __builtin_amdgcn_cvt_pk_f32_fp8((int)c.x, false), c1 = __builtin_amdgcn_cvt_pk_f32_fp8((int)c.x, true), c2 = __builtin_amdgcn_cvt_pk_f32_fp8((int)c.y, false), c3 = __builtin_amdgcn_cvt_pk_f32_fp8((int)c.y, true);
            const float ys = 0.0625f;
            v[8 * j + 0] = bf_lo(a.x) + (b0[0] + c0[0]) * ys; v[8 * j + 1] = bf_hi(a.x) + (b0[1] + c0[1]) * ys;
            v[8 * j + 2] = bf_lo(a.y) + (b1[0] + c1[0]) * ys; v[8 * j + 3] = bf_hi(a.y) + (b1[1] + c1[1]) * ys;
            v[8 * j + 4] = bf_lo(a.z) + (b2[0] + c2[0]) * ys; v[8 * j + 5] = bf_hi(a.z) + (b2[1] + c2[1]) * ys;
            v[8 * j + 6] = bf_lo(a.w) + (b3[0] + c3[0]) * ys; v[8 * j + 7] = bf_hi(a.w) + (b3[1] + c3[1]) * ys; }
        if constexpr (!FINAL) {
            u32x4 w[2]; float s = 0.f;
#pragma unroll
            for (int j = 0; j < 2; ++j) { w[j].x = pk2(v[8 * j], v[8 * j + 1]); w[j].y = pk2(v[8 * j + 2], v[8 * j + 3]); w[j].z = pk2(v[8 * j + 4], v[8 * j + 5]); w[j].w = pk2(v[8 * j + 6], v[8 * j + 7]);
                const float q0 = bf_lo(w[j].x), q1 = bf_hi(w[j].x), q2 = bf_lo(w[j].y), q3 = bf_hi(w[j].y), q4 = bf_lo(w[j].z), q5 = bf_hi(w[j].z), q6 = bf_lo(w[j].w), q7 = bf_hi(w[j].w);
                s += (q0 * q0 + q1 * q1) + (q2 * q2 + q3 * q3) + (q4 * q4 + q5 * q5) + (q6 * q6 + q7 * q7); }
            s = wave_sum(s);
            u32x4* op = (u32x4*)(HO + (size_t)t * D) + lane; op[0] = w[0]; op[64] = w[1];
            if (lane == 0) rs_out[t] = 1.0f / sqrtf(s * (1.0f / D) + EPS);
        } else {
            float s = 0.f;
#pragma unroll
            for (int j = 0; j < 16; ++j) s += v[j] * v[j];
            s = wave_sum(s);
            const float r = 1.0f / sqrtf(s * (1.0f / D) + EPS);
#pragma unroll
            for (int j = 0; j < 2; ++j) { const int c0 = 512 * j + 8 * lane; const f32x4 g0 = *(const f32x4*)(fn + c0), g1 = *(const f32x4*)(fn + c0 + 4);
                float* op = outp + (size_t)t * D + c0;
                __builtin_nontemporal_store((f32x4){v[8 * j] * r * g0[0], v[8 * j + 1] * r * g0[1], v[8 * j + 2] * r * g0[2], v[8 * j + 3] * r * g0[3]}, (f32x4*)op);
                __builtin_nontemporal_store((f32x4){v[8 * j + 4] * r * g1[0], v[8 * j + 5] * r * g1[1], v[8 * j + 6] * r * g1[2], v[8 * j + 7] * r * g1[3]}, (f32x4*)(op + 4)); }
        }
    };
    const int TS = ((T * 3 / 4) / 16) * 16, NTK = (T - TS) / 16;
    for (int t = gw; t < TS; t += NGW) row(t);
    volatile LAS int* tkl = (volatile LAS int*)(F.lds + MISC_OFF + 160);
    if (F.tid == 0) tkl[0] = (int)__hip_atomic_fetch_add(ticket, 1u, __ATOMIC_RELAXED, __HIP_MEMORY_SCOPE_AGENT);
    __syncthreads();
    for (int slot = 0;; slot ^= 1) {
        const int tk = tkl[slot];
        if (tk >= NTK) break;
        int nx = 0;
        if (F.tid == 0) nx = (int)__hip_atomic_fetch_add(ticket, 1u, __ATOMIC_RELAXED, __HIP_MEMORY_SCOPE_AGENT);
        row(TS + tk * 16 + F.wave); row(TS + tk * 16 + 8 + F.wave);
        if (F.tid == 0) tkl[slot ^ 1] = nx;
        __syncthreads();
    }
}
__device__ __forceinline__ void conv_phase(Frame& F) {
    const bf16_t* BG = (const bf16_t*)(WSP + WS_BG); const bf16_t* Z = (const bf16_t*)(WSP + WS_Z); unsigned char* A4 = WSP + WS_A4;   const float* cw = IN_F(11);
    const int c0 = (F.tid & 127) * 8;
    float w0[8], w1[8], w2[8];
#pragma unroll
    for (int j = 0; j < 8; ++j) { w0[j] = cw[c0 + j]; w1[j] = cw[D + c0 + j]; w2[j] = cw[2 * D + c0 + j]; }
    for (int t = F.bid * 4 + (F.tid >> 7); t < T; t += F.G * 4) {
        const int pos = t & (SEQ - 1);
        const u32x4 b = *(const u32x4*)(BG + (size_t)t * D + c0), z2 = *(const u32x4*)(Z + (size_t)t * D + c0);
        u32x4 z1 = {0u, 0u, 0u, 0u}, z0 = {0u, 0u, 0u, 0u};
        if (pos >= 1) z1 = *(const u32x4*)(Z + (size_t)(t - 1) * D + c0);
        if (pos >= 2) z0 = *(const u32x4*)(Z + (size_t)(t - 2) * D + c0);
        float r[8];
#define CV(j, comp, part) r[j] = part(b.comp) * (w0[j] * part(z0.comp) + w1[j] * part(z1.comp) + w2[j] * part(z2.comp))
        CV(0, x, bf_lo); CV(1, x, bf_hi); CV(2, y, bf_lo); CV(3, y, bf_hi); CV(4, z, bf_lo); CV(5, z, bf_hi); CV(6, w, bf_lo); CV(7, w, bf_hi);
#undef CV
        u32x2 o; o.x = pk4_fp8(r[0] * 4.f, r[1] * 4.f, r[2] * 4.f, r[3] * 4.f); o.y = pk4_fp8(r[4] * 4.f, r[5] * 4.f, r[6] * 4.f, r[7] * 4.f);
        *(u32x2*)(A4 + (size_t)t * D + c0) = o;
    }
}

constexpr int N_PHASES = 15;
#ifndef PH_MASK
#define PH_MASK 0x7fff
#endif
#ifndef REPEAT_MASK
#define REPEAT_MASK 0
#endif
__global__ void __launch_bounds__(NTHR, 2) mk_fwd(Args args) {
    __shared__ __attribute__((aligned(16))) unsigned char lds_raw[LDS_BYTES];
    Frame F0;
    F0.lds = (LAS unsigned char*)lds_raw;
    F0.tid = threadIdx.x; F0.lane = F0.tid & 63; F0.wave = __builtin_amdgcn_readfirstlane(F0.tid >> 6);
    F0.G = gridDim.x; F0.bid = blockIdx.x;
    const Frame& F = F0;
    if (F.tid < (LDSCTL_END - LDSCTL_OFF) / 4) ((LAS unsigned*)(F.lds + LDSCTL_OFF))[F.tid] = 0u;
    if (F.tid == 0) {
#pragma unroll
        for (int i = 0; i < 19; ++i) { ((volatile LAS unsigned long long*)(F.lds + PT_OFF))[i] = (unsigned long long)args.in[i]; }
        ((volatile LAS unsigned long long*)(F.lds + PT_OFF))[19] = (unsigned long long)args.ws;
        ((volatile LAS unsigned long long*)(F.lds + PT_OFF))[20] = (unsigned long long)args.out;
    }
    __syncthreads();
    if (MK_N_LAUNCHES != N_PHASES) (void)xcd_barrier_post((unsigned*)(args.ws + WS_CTL) + CW_BAR, (volatile LAS unsigned*)(F.lds + MISC_OFF) + 8);
    const int lo = args.ph_lo, hi = args.ph_hi;
#pragma unroll 1
    for (int ph2 = 2 * lo; ph2 < 2 * hi; ++ph2) {
        const int ph = ph2 >> 1;
        if ((ph2 & 1) && !((REPEAT_MASK >> (ph >= 11 ? ph - 7 : ph)) & 1)) continue;
        Frame F = F0;
        int wv = F0.wave; asm volatile("" : "+s"(wv)); asm volatile("" : "+s"(F.G), "+s"(F.bid));
        unsigned ones = ~0u; asm volatile("" : "+s"(ones));
        F.wave = wv; F.lane = (int)__builtin_amdgcn_mbcnt_hi(ones, __builtin_amdgcn_mbcnt_lo(ones, 0u));
        F.tid = F.wave * 64 + F.lane;
        const int layer = ph >= 11 ? 1 : 0;
        const int k = ph >= 11 ? ph - 7 : ph;
        if ((PH_MASK >> k) & 1) {
          {
            switch (k) {
            case 0: p0_prologue(F); break;
            case 1: { PolQKV P; P.init(WSP + WS_XB, WSP + WS_WQKV, D, QKVD, F.G, F.bid); P.O = (bf16_t*)(WSP + WS_QKV); P.side = (const float*)(WSP + WS_RS0); P.bias = IN_F(6); pg8::gemm_phase(F.lds + RING_OFF, F.lds, F.tid, P);
                if (F.bid >= (5 * 128) % F.G && (5 * 128) % F.G != 0) conv_steal(F, 24, NITEMS, false); } break;
            case 2: attn_phase(F); conv_steal(F, 64, Q_O, true); break;
            case 3: { PolOproj P; P.init(WSP + WS_O, WSP + WS_WO, D / 2, D, F.G, F.bid); P.scale_w = 0x79797979; P.scale_a = 0x7d7d7d7d;   P.O = (bf16_t*)(WSP + WS_HA); P.xb = (const bf16_t*)(WSP + WS_XB); P.bias = IN_F(8); P.ssq = (float*)(WSP + WS_SSQ); P.H8 = WSP + WS_H8; pg8::gemm_phase(F.lds + RING_OFF, F.lds, F.tid, P); } break;
            case 4: { PolRoute P; P.init(WSP + WS_HA, WSP + WS_WR + (size_t)layer * 256 * 1024 * 2, D, 256, F.G, F.bid); P.lds = F.lds + RING_OFF; P.ssq = (const float*)(WSP + WS_SSQ); P.bg = IN_F(14) + layer * 4; P.be = IN_F(16) + layer * 32;
                P.ecount = (unsigned*)(WSP + WS_CTL) + CW_ECNT + layer * 64; P.elist = (int*)(WSP + WS_ELIST); P.gate = (float*)(WSP + WS_GATE); P.ascale = (float*)(WSP + WS_ASCALE); P.tid = F.tid; pg8::gemm_phase(F.lds + RING_OFF, F.lds, F.tid, P);
                if (F.bid >= 128) conv_steal(F, 32, NITEMS, false);
                conv_steal(F, 64, layer == 0 ? Q_GU0 : Q_GU1, true); } break;
            case 5: { moe_build_etab(F, (const unsigned*)(WSP + WS_CTL) + CW_ECNT + layer * 64);
                PolMoe1 P; P.Abase = (const char*)(WSP + WS_H8); P.W = (const char*)(WSP + WS_WGU) + (size_t)layer * 32 * 1024 * D; P.K = D / 2; P.G = F.G; P.c = F.bid; P.wstride = (size_t)1024 * D; P.scale_w = 0x79797979; P.scale_a = 0x7f7f7f7f;
                P.elist = (const int*)(WSP + WS_ELIST); P.etab = (LAS int*)(F.lds + ETAB_OFF); P.ACT = WSP + WS_ACT; P.ascale = (const float*)(WSP + WS_ASCALE); pg8::gemm_phase(F.lds + RING_OFF, F.lds, F.tid, P);
                { const int nwg = ((LAS int*)(F.lds + ETAB_OFF))[64] * 4, r = nwg % F.G; if (r != 0 && F.bid >= r) conv_steal(F, 12, NITEMS, false); }
                conv_steal(F, 64, layer == 0 ? Q_L0 : Q_L1, true); } break;
            case 6: {
#if MK_N_LAUNCHES != 1
                moe_build_etab(F, (const unsigned*)(WSP + WS_CTL) + CW_ECNT + layer * 64);
#endif
                PolMoe2 P; P.Abase = (const char*)(WSP + WS_ACT); P.W = (const char*)(WSP + WS_WDN) + (size_t)layer * 32 * D * FF; P.K = FF / 2; P.G = F.G; P.c = F.bid; P.wstride = (size_t)D * FF; P.scale_w = 0x7a7a7a7a; P.scale_a = 0x7d7d7d7d;
                P.elist = (const int*)(WSP + WS_ELIST); P.etab = (LAS int*)(F.lds + ETAB_OFF); P.Y = WSP + WS_Y; P.gate = (const float*)(WSP + WS_GATE); pg8::gemm_phase(F.lds + RING_OFF, F.lds, F.tid, P);
                if (layer == 0) { const int nwg = ((LAS int*)(F.lds + ETAB_OFF))[64] * 4, r = nwg % F.G; if (r != 0 && F.bid >= r) conv_steal(F, 8, NITEMS, false); } } break;
            case 7: if (layer == 0) { combine_phase<false>(F, (const bf16_t*)(WSP + WS_HA), (const unsigned char*)(WSP + WS_Y), (bf16_t*)(WSP + WS_HB), (float*)(WSP + WS_RS2), (unsigned*)(WSP + WS_CTL) + CW_DYN + 16 * ph); conv_steal(F, 64, Q_IN, true); }
                    else combine_phase<true>(F, (const bf16_t*)(WSP + WS_HA), (const unsigned char*)(WSP + WS_Y), nullptr, nullptr, (unsigned*)(WSP + WS_CTL) + CW_DYN + 16 * ph);
                    break;
            case 8: { PolConvIn P; P.init(WSP + WS_HB, WSP + WS_WIN, D, 3 * D, F.G, F.bid); P.BG = (bf16_t*)(WSP + WS_BG); P.Z = (bf16_t*)(WSP + WS_Z); P.side = (const float*)(WSP + WS_RS2); pg8::gemm_phase(F.lds + RING_OFF, F.lds, F.tid, P); } break;
            case 9: conv_phase(F); conv_steal(F, 64, Q_OUT, true); break;
            case 10: { PolConvOut P; P.init(WSP + WS_A4, WSP + WS_WOUT, D / 2, D, F.G, F.bid); P.scale_w = 0x79797979; P.scale_a = 0x7d7d7d7d;   P.O = (bf16_t*)(WSP + WS_HA); P.H = (const bf16_t*)(WSP + WS_HB); P.ssq = (float*)(WSP + WS_SSQ); P.H8 = WSP + WS_H8; pg8::gemm_phase(F.lds + RING_OFF, F.lds, F.tid, P); } break;
            default: break;
            }
          }
        }
        if ((ph + 1 < hi) || (!(ph2 & 1) && ((REPEAT_MASK >> k) & 1))) { XcdBarrier bar; bar.bar = (unsigned*)(WSP + WS_CTL) + CW_BAR; bar.x = xb_xcc_id(); bar.st = (volatile LAS unsigned*)(F.lds + MISC_OFF) + 8; xcd_barrier(bar);
#ifdef PROBE_DOUBLE_BAR
            xcd_barrier(bar);
#endif
        }
    }
}

extern "C" void kernel_launch(void* const* d_in, const int* in_sizes, int n_in, void* d_out, int out_size, void* d_ws, size_t ws_size, hipStream_t stream) {
    static int grid = 0;
    if (grid == 0) {
        if (n_in != 19 || in_sizes[0] != T * D || out_size != T * D || ws_size < WS_END) { fprintf(stderr, "kernel_launch: unexpected shapes (n_in %d, in0 %d, out %d, ws %zu); nothing launched\n", n_in, n_in > 0 ? in_sizes[0] : -1, out_size, ws_size); grid = -1; return; }
        int dev = 0, cus = 0;
        if (hipGetDevice(&dev) != hipSuccess || hipDeviceGetAttribute(&cus, hipDeviceAttributeMultiprocessorCount, dev) != hipSuccess) { grid = -1; return; }
        int per_cu = 0;
        if (hipOccupancyMaxActiveBlocksPerMultiprocessor(&per_cu, (const void*)mk_fwd, NTHR, 0) != hipSuccess || per_cu < 1) fprintf(stderr, "kernel_launch: occupancy query reports %d workgroups per CU\n", per_cu);
        (void)hipGetLastError();
        grid = cus;
    }
    if (grid < 0) return;
    if (hipMemsetAsync((char*)d_ws + WS_CTL, 0, CTL_ZERO_BYTES, stream) != hipSuccess) { fprintf(stderr, "kernel_launch: hipMemsetAsync failed\n"); return; }
    Args a{};
    for (int i = 0; i < 19; ++i) a.in[i] = (const float*)d_in[i];
    a.out = (float*)d_out; a.ws = (unsigned char*)d_ws;
#if MK_N_LAUNCHES == 1
    a.ph_lo = 0; a.ph_hi = N_PHASES; a.li = 0;
    hipLaunchKernelGGL(mk_fwd, dim3(grid), dim3(NTHR), 0, stream, a);
#else
    for (int li = 0; li < N_PHASES; ++li) { a.ph_lo = li; a.ph_hi = li + 1; a.li = 0; hipLaunchKernelGGL(mk_fwd, dim3(grid), dim3(NTHR), 0, stream, a); }
#endif
    const hipError_t le = hipPeekAtLastError();
    if (le != hipSuccess) fprintf(stderr, "kernel_launch: launch failed: %s\n", hipGetErrorName(le));
}
```
